# Optimizing an MI355X kernel written in HIP

```python
import math
import jax
import jax.numpy as jnp
from jax import lax

D_MODEL = 1024
BATCH = 2
SEQ = 8192
DEPTH = 4

GRID_W = 64
CTX_LEN = 256
HEAD_DIM = 64
A_HEADS = 4
B_HEADS = 8
B_KV = 2
C_HEADS = 8
C_KV = 2
WINDOW = 128
QBLK = 128
D_FF = 4 * D_MODEL
ROPE_THETA = 10000.0
EPS = 1e-6
SUBLN_EPS = 1e-5

A_W = A_HEADS * 2 * HEAD_DIM
B_W = B_HEADS * HEAD_DIM
C_W = C_HEADS * HEAD_DIM
MIX_W = A_W + B_W + C_W
B_KW = B_KV * HEAD_DIM
C_KW = C_KV * HEAD_DIM
IN_SIZES = (A_W, A_W, A_W, B_W, B_KW, B_KW, C_W, C_KW, C_KW, 3 * D_MODEL)
IN_SPLITS = tuple(sum(IN_SIZES[:i + 1]) for i in range(len(IN_SIZES) - 1))
IN_W = sum(IN_SIZES)

kernel_name = 'hybrid_diffusion_trunk'


def rms_norm(x, gain, eps=EPS):
    x32 = x.astype(jnp.float32)
    y = x32 * lax.rsqrt(jnp.mean(jnp.square(x32), axis=-1, keepdims=True) + eps)
    return (y * gain.astype(jnp.float32)).astype(x.dtype)


def modulate(x, gain, shift, scale):
    return rms_norm(x, gain) * (1 + scale) + shift


def axial_tables(rows):
    row = jnp.repeat(jnp.arange(rows, dtype=jnp.int32), GRID_W).astype(jnp.float32)
    col = jnp.tile(jnp.arange(GRID_W, dtype=jnp.int32), rows).astype(jnp.float32)
    half = HEAD_DIM // 2
    inv_freq = jnp.power(ROPE_THETA, -jnp.arange(0, half, 2, dtype=jnp.float32) / half)
    ang_r = row[:, None] * inv_freq[None, :]
    ang_c = col[:, None] * inv_freq[None, :]
    return (jnp.cos(ang_r)[None, :, None, :], jnp.sin(ang_r)[None, :, None, :],
            jnp.cos(ang_c)[None, :, None, :], jnp.sin(ang_c)[None, :, None, :])


def _rot(x, cos, sin):
    x1, x2 = jnp.split(x, 2, axis=-1)
    return jnp.concatenate([x1 * cos - x2 * sin, x2 * cos + x1 * sin], axis=-1)


def rope_2d(x, tabs):
    cos_r, sin_r, cos_c, sin_c = tabs
    xr, xc = jnp.split(x.astype(jnp.float32), 2, axis=-1)
    return jnp.concatenate([_rot(xr, cos_r, sin_r), _rot(xc, cos_c, sin_c)], axis=-1).astype(x.dtype)


def rope_pairs(x, tabs):
    b, n, h, m, d = x.shape
    return rope_2d(x.reshape(b, n, h * m, d), tabs).reshape(b, n, h, m, d)


def split_proj(p):
    b, n, _ = p.shape
    qa, ka, va, qb, kb, vb, qc, kc, vc, gt = jnp.split(p, IN_SPLITS, axis=-1)
    return (qa.reshape(b, n, A_HEADS, 2, HEAD_DIM), ka.reshape(b, n, A_HEADS, 2, HEAD_DIM),
            va.reshape(b, n, A_HEADS, 2 * HEAD_DIM),
            qb.reshape(b, n, B_HEADS, HEAD_DIM), kb.reshape(b, n, B_KV, HEAD_DIM), vb.reshape(b, n, B_KV, HEAD_DIM),
            qc.reshape(b, n, C_HEADS, HEAD_DIM), kc.reshape(b, n, C_KV, HEAD_DIM), vc.reshape(b, n, C_KV, HEAD_DIM),
            gt)


def gqa_attend(q, k, v, sink=None):
    b, sq, h, d = q.shape
    kvh = k.shape[2]
    g = h // kvh
    nblk = sq // QBLK
    scale = d ** -0.5
    qb = q.reshape(b, nblk, QBLK, kvh, g, d).transpose(1, 0, 2, 3, 4, 5)

    def block(qi):
        s = jnp.einsum('bqngd,bknd->bngqk', qi, k, preferred_element_type=jnp.float32) * scale
        if sink is None:
            p = jax.nn.softmax(s, axis=-1)
        else:
            sk = sink.astype(jnp.float32).reshape(1, kvh, g, 1, 1)
            m = jnp.maximum(jnp.max(s, axis=-1, keepdims=True), sk)
            e = jnp.exp(s - m)
            p = e / (jnp.sum(e, axis=-1, keepdims=True) + jnp.exp(sk - m))
        return jnp.einsum('bngqk,bkne->bqnge', p.astype(v.dtype), v)

    o = lax.map(block, qb)
    return o.transpose(1, 0, 2, 3, 4, 5).reshape(b, sq, h, v.shape[-1])


def diff_attend(q, k, v, lam):
    b, sq, h, _, d = q.shape
    nblk = sq // QBLK
    scale = d ** -0.5
    qb = q.reshape(b, nblk, QBLK, h, 2, d).transpose(1, 0, 2, 3, 4, 5)

    def block(qi):
        s = jnp.einsum('bqhmd,bkhmd->bhmqk', qi, k, preferred_element_type=jnp.float32) * scale
        p = jax.nn.softmax(s, axis=-1)
        pd = p[:, :, 0] - lam * p[:, :, 1]
        return jnp.einsum('bhqk,bkhe->bqhe', pd.astype(v.dtype), v)

    o = lax.map(block, qb)
    return o.transpose(1, 0, 2, 3, 4).reshape(b, sq, h, v.shape[-1])


def window_attend(q, k, v, kc, vc, sink):
    b, s, h, d = q.shape
    kvh = k.shape[2]
    g = h // kvh
    nblk = s // QBLK
    scale = d ** -0.5

    def band(t):
        tp = jnp.pad(t, ((0, 0), (QBLK, QBLK), (0, 0), (0, 0))).reshape(b, nblk + 2, QBLK, kvh, t.shape[-1])
        return jnp.concatenate([tp[:, :-2], tp[:, 1:-1], tp[:, 2:]], axis=2)

    kband, vband = band(k), band(v)
    qb = q.reshape(b, nblk, QBLK, kvh, g, d)
    s_loc = jnp.einsum('bjqngd,bjknd->bjngqk', qb, kband, preferred_element_type=jnp.float32) * scale
    s_ctx = jnp.einsum('bjqngd,bknd->bjngqk', qb, kc, preferred_element_type=jnp.float32) * scale
    blk = jnp.arange(nblk, dtype=jnp.int32)[:, None, None]
    qpos = blk * QBLK + jnp.arange(QBLK, dtype=jnp.int32)[None, :, None]
    kpos = (blk - 1) * QBLK + jnp.arange(3 * QBLK, dtype=jnp.int32)[None, None, :]
    valid = (jnp.abs(kpos - qpos) <= WINDOW) & (kpos >= 0) & (kpos < s)
    s_loc = jnp.where(valid[None, :, None, None], s_loc, -jnp.inf)
    sk = sink.astype(jnp.float32).reshape(1, 1, kvh, g, 1, 1)
    m = jnp.maximum(jnp.maximum(jnp.max(s_loc, axis=-1, keepdims=True), jnp.max(s_ctx, axis=-1, keepdims=True)), sk)
    e_loc = jnp.exp(s_loc - m)
    e_ctx = jnp.exp(s_ctx - m)
    denom = jnp.sum(e_loc, axis=-1, keepdims=True) + jnp.sum(e_ctx, axis=-1, keepdims=True) + jnp.exp(sk - m)
    o = (jnp.einsum('bjngqk,bjkne->bjqnge', (e_loc / denom).astype(v.dtype), vband)
         + jnp.einsum('bjngqk,bkne->bjqnge', (e_ctx / denom).astype(v.dtype), vc))
    return o.reshape(b, s, h, v.shape[-1])


def diff_post(o, g_subln, lam_init):
    b, n = o.shape[:2]
    return (rms_norm(o, g_subln, SUBLN_EPS) * (1.0 - lam_init)).reshape(b, n, A_W)


def flat_heads(o):
    b, n = o.shape[:2]
    return o.reshape(b, n, -1)


def merge_branches(oa, ob, oc, gt, w_branch, w_out):
    ga, gb, gc = jnp.split(jax.nn.sigmoid(gt), 3, axis=-1)
    z = (ga * (oa @ w_branch[:A_W]) + gb * (ob @ w_branch[A_W:A_W + B_W])
         + gc * (oc @ w_branch[A_W + B_W:]))
    return z @ w_out


def sq_relu_mlp(h, w1, w2):
    return jnp.square(jax.nn.relu(h @ w1)) @ w2


def setup_inputs(seed: int = 0) -> dict:
    key = jax.random.key(seed)
    ks = jax.random.split(key, 24)
    f32 = jnp.float32
    L = DEPTH

    def nrm(k, shape, scale):
        return jax.random.normal(k, shape, f32) * scale

    return {
        'x': nrm(ks[0], (BATCH, SEQ, D_MODEL), 1.0),
        'c': nrm(ks[1], (BATCH, D_MODEL), 1.0),
        'ctx': nrm(ks[2], (BATCH, CTX_LEN, D_MODEL), 1.0),
        'c_ctx': nrm(ks[3], (D_MODEL,), 1.0),
        'w_ada': nrm(ks[4], (L, D_MODEL, 6 * D_MODEL), 0.5 * D_MODEL ** -0.5),
        'b_ada': nrm(ks[5], (L, 6 * D_MODEL), 0.01),
        'g_pre_mix': 1.0 + nrm(ks[6], (L, D_MODEL), 0.02),
        'g_post_mix': 1.0 + nrm(ks[7], (L, D_MODEL), 0.02),
        'g_pre_ff': 1.0 + nrm(ks[8], (L, D_MODEL), 0.02),
        'g_post_ff': 1.0 + nrm(ks[9], (L, D_MODEL), 0.02),
        'w_in': nrm(ks[10], (L, D_MODEL, IN_W), D_MODEL ** -0.5),
        'g_qnorm': 1.0 + nrm(ks[11], (L, HEAD_DIM), 0.02),
        'g_knorm': 1.0 + nrm(ks[12], (L, HEAD_DIM), 0.02),
        'lam_q1': nrm(ks[13], (L, HEAD_DIM), 0.1),
        'lam_k1': nrm(ks[14], (L, HEAD_DIM), 0.1),
        'lam_q2': nrm(ks[15], (L, HEAD_DIM), 0.1),
        'lam_k2': nrm(ks[16], (L, HEAD_DIM), 0.1),
        'g_subln': 1.0 + nrm(ks[17], (L, 2 * HEAD_DIM), 0.02),
        'sink': nrm(ks[18], (L, C_HEADS), 0.5),
        'w_branch': nrm(ks[19], (L, MIX_W, D_MODEL), A_W ** -0.5),
        'w_out': nrm(ks[20], (L, D_MODEL, D_MODEL), D_MODEL ** -0.5),
        'w_ff1': nrm(ks[21], (L, D_MODEL, D_FF), D_MODEL ** -0.5),
        'w_ff2': nrm(ks[22], (L, D_FF, D_MODEL), D_FF ** -0.5),
    }


def reference(x, c, ctx, c_ctx, w_ada, b_ada, g_pre_mix, g_post_mix, g_pre_ff, g_post_ff, w_in, g_qnorm, g_knorm,
              lam_q1, lam_k1, lam_q2, lam_k2, g_subln, sink, w_branch, w_out, w_ff1, w_ff2):
    n_tok = x.shape[1]
    rows = n_tok // GRID_W
    tabs = axial_tables(rows)
    y = ctx
    silu_c = jax.nn.silu(c)
    silu_cc = jax.nn.silu(c_ctx)
    for l in range(DEPTH):
        lam_init = 0.8 - 0.6 * math.exp(-0.3 * l)
        lam = (jnp.exp(jnp.sum(lam_q1[l].astype(jnp.float32) * lam_k1[l].astype(jnp.float32)))
               - jnp.exp(jnp.sum(lam_q2[l].astype(jnp.float32) * lam_k2[l].astype(jnp.float32))) + lam_init)
        sh1, sc1, gm1, sh2, sc2, gm2 = jnp.split((silu_c @ w_ada[l] + b_ada[l])[:, None, :], 6, axis=-1)
        csh1, csc1, cgm1, csh2, csc2, cgm2 = jnp.split((silu_cc @ w_ada[l] + b_ada[l])[None, None, :], 6, axis=-1)

        qa_x, ka_x, va_x, qb_x, kb_x, vb_x, qc_x, kc_x, vc_x, gt_x = split_proj(
            modulate(x, g_pre_mix[l], sh1, sc1) @ w_in[l])
        qa_y, ka_y, va_y, qb_y, kb_y, vb_y, qc_y, kc_y, vc_y, gt_y = split_proj(
            modulate(y, g_pre_mix[l], csh1, csc1) @ w_in[l])
        qa_x = rope_pairs(qa_x, tabs)
        ka_x = rope_pairs(ka_x, tabs)
        qb_x = rope_2d(rms_norm(qb_x, g_qnorm[l]), tabs)
        kb_x = rope_2d(rms_norm(kb_x, g_knorm[l]), tabs)
        kb_y = rms_norm(kb_y, g_knorm[l])
        qc_x = rope_2d(qc_x, tabs)
        kc_x = rope_2d(kc_x, tabs)

        oa_x = diff_attend(qa_x, jnp.concatenate([ka_x, ka_y], axis=1), jnp.concatenate([va_x, va_y], axis=1), lam)
        ob_x = gqa_attend(qb_x, jnp.concatenate([kb_x, kb_y], axis=1), jnp.concatenate([vb_x, vb_y], axis=1))
        oc_x = window_attend(qc_x, kc_x, vc_x, kc_y, vc_y, sink[l])
        mix_x = merge_branches(diff_post(oa_x, g_subln[l], lam_init), flat_heads(ob_x), flat_heads(oc_x),
                               gt_x, w_branch[l], w_out[l])
        x = x + gm1 * rms_norm(mix_x, g_post_mix[l])
        x = x + gm2 * rms_norm(sq_relu_mlp(modulate(x, g_pre_ff[l], sh2, sc2), w_ff1[l], w_ff2[l]), g_post_ff[l])

        if l < DEPTH - 1:
            qb_y = rms_norm(qb_y, g_qnorm[l])
            oa_y = diff_attend(qa_y, ka_y, va_y, lam)
            ob_y = gqa_attend(qb_y, kb_y, vb_y)
            oc_y = gqa_attend(qc_y, kc_y, vc_y, sink[l])
            mix_y = merge_branches(diff_post(oa_y, g_subln[l], lam_init), flat_heads(ob_y), flat_heads(oc_y),
                                   gt_y, w_branch[l], w_out[l])
            y = y + cgm1 * rms_norm(mix_y, g_post_mix[l])
            y = y + cgm2 * rms_norm(sq_relu_mlp(modulate(y, g_pre_ff[l], csh2, csc2), w_ff1[l], w_ff2[l]),
                                    g_post_ff[l])
    return x
```

```cpp
#include <hip/hip_runtime.h>
#include <hip/hip_cooperative_groups.h>
#include <cstdio>
#include <cstdint>
namespace cg = cooperative_groups;
namespace pg8 {
#define PG8_LAS __attribute__((address_space(3)))
typedef unsigned short bf16_t;
typedef short bf16x8 __attribute__((ext_vector_type(8)));
typedef float f32x4 __attribute__((ext_vector_type(4)));
typedef unsigned u32x4 __attribute__((ext_vector_type(4)));
constexpr int BM = 256, BK = 64, HALF = 128, HTB = HALF * BK * 2  , STAGE_BYTES = 8 * HTB, NXCD = 8, WGM = 8;

__host__ __device__ __forceinline__ int lds_byte(int r, int c) { const int st = (r >> 4) * 2 + (c >> 5), rr = r & 15, cc = c & 31, ob = rr * 64 + cc * 2; return st * 1024 + (ob ^ (((ob >> 9) & 1) << 5)); }
__host__ __device__ __forceinline__ void stage_rc(int b, int& R, int& C) { const int st = b / 1024, sb = b % 1024, swz = sb ^ (((sb >> 9) & 1) << 5); R = (st >> 1) * 16 + swz / 64; C = (st & 1) * 32 + (swz % 64) / 2; }
__host__ __device__ __forceinline__ int perm32(int rho) { const int n = rho >> 4, i = rho & 15; return 8 * (i >> 2) + 4 * n + (i & 3); }

struct Unit { int pm, pn, koff, nt; };
struct Gemm { const bf16_t* A; const bf16_t* Bt; int M, N, K; };

struct StaticOrder {
    int nM, nN, nwg, G, c;
    __host__ __device__ void init(int M, int N, int G_, int c_) { nM = M / BM; nN = N / BM; nwg = nM * nN; G = G_; c = c_; }
    __host__ __device__ bool next(int i, Unit& u) const {
        const long L = (long)i * G + c; if (L >= nwg) return false;
        int wgid = (int)L; { const int q = nwg / NXCD, r = nwg % NXCD, xcd = wgid % NXCD, off = wgid / NXCD; wgid = (xcd < r ? xcd * (q + 1) : r * (q + 1) + (xcd - r) * q) + off; }
        const int nig = WGM * nN, gid = wgid / nig, fm = gid * WGM, gsz = (nM - fm) < WGM ? (nM - fm) : WGM;
        u.pm = fm + ((wgid % nig) % gsz); u.pn = (wgid % nig) / gsz; u.koff = 0; u.nt = 0; return true;
    }
    __device__ __forceinline__ void a_ready(const Unit&) const {}
    __device__ __forceinline__ void done(const Unit&) const {}
};

template <class Epi, class Sched, bool ALIGN_EPI = false, bool SP2 = false>
__device__ __forceinline__ void gemm_phase(PG8_LAS unsigned char* lds, const Gemm g, const Sched& S, const Epi& E) {
    int tid_ = threadIdx.x; asm volatile("" : "+v"(tid_)); const int tid = tid_, wid = __builtin_amdgcn_readfirstlane(tid >> 6), lane = tid & 63, wr = wid >> 2, wc = wid & 3, fr = lane & 15, fq = lane >> 4;
    const int K = g.K, nt_full = K / BK;
    unsigned voffA[2], voffB[2];
#pragma unroll
    for (int i = 0; i < 2; ++i) { int R, C; stage_rc(tid * 16 + i * 8192, R, C); const int Rb = Epi::PERM ? ((R & ~31) + perm32(R & 31)) : R;
        voffA[i] = (unsigned)(R * K + C) * 2u; voffB[i] = (unsigned)(Rb * K + C) * 2u; }
    const size_t kstep = (size_t)(BK * 2);
    const size_t hstep = (size_t)HALF * K * 2;
    const size_t tstep = 2 * hstep;
    const unsigned ldsw = (unsigned)wid * 1024u;
    const int aoff = lds_byte(wr * 64 + fr, fq * 8), boff = lds_byte(wc * 32 + fr, fq * 8);
#define PG8_SA(b, h) (((b) * 2 + (h)) * HTB)
#define PG8_SB(b, h) ((4 + (b) * 2 + (h)) * HTB)
#define PG8_STAGE(bufoff, gbase, voff) do { _Pragma("unroll") for (int _i = 0; _i < 2; ++_i) \
        __builtin_amdgcn_global_load_lds((const unsigned*)((const char*)(gbase) + (voff)[_i]), (PG8_LAS unsigned*)(lds + (bufoff) + ldsw + _i * 8192), 16, 0, 0); } while (0)
#define PG8_LDA(dst, b, h) do { _Pragma("unroll") for (int m = 0; m < 4; ++m) _Pragma("unroll") for (int k = 0; k < 2; ++k) dst[m][k] = *(const PG8_LAS bf16x8*)(lds + PG8_SA(b, h) + aoff + m * 2048 + k * 1024); } while (0)
#define PG8_LDB(dst, b, h) do { _Pragma("unroll") for (int n = 0; n < 2; ++n) _Pragma("unroll") for (int k = 0; k < 2; ++k) dst[n][k] = *(const PG8_LAS bf16x8*)(lds + PG8_SB(b, h) + boff + n * 2048 + k * 1024); } while (0)
#define PG8_MMA(ai, bj, At, Bt) do { __builtin_amdgcn_s_setprio(1); _Pragma("unroll") for (int m = 0; m < 4; ++m) _Pragma("unroll") for (int n = 0; n < 2; ++n) _Pragma("unroll") for (int k = 0; k < 2; ++k) \
        acc[ai][bj][m][n] = __builtin_amdgcn_mfma_f32_16x16x32_bf16(Bt[n][k], At[m][k], acc[ai][bj][m][n], 0, 0, 0); __builtin_amdgcn_s_setprio(0); } while (0)
#define PG8_WAIT_V(n) asm volatile("s_waitcnt vmcnt(" #n ")" ::: "memory")
#define PG8_WAIT_L(n) asm volatile("s_waitcnt lgkmcnt(" #n ")" ::: "memory")
#define PG8_BAR __builtin_amdgcn_s_barrier()
#define PG8_SCHED __builtin_amdgcn_sched_barrier(0)
    Unit cur, nxt; int ui = 0;
    if (!S.next(0, cur)) return;
    f32x4 acc[2][2][4][2];
#pragma unroll
    for (int a = 0; a < 2; ++a)
#pragma unroll
        for (int b = 0; b < 2; ++b)
#pragma unroll
            for (int m = 0; m < 4; ++m)
#pragma unroll
                for (int n = 0; n < 2; ++n) acc[a][b][m][n] = (f32x4){0.f, 0.f, 0.f, 0.f};
    bf16x8 At[4][2], B0[2][2], B1[2][2];
    const char* cA = (const char*)g.A + (size_t)cur.pm * tstep + (size_t)cur.koff * 2; const char* cB = (const char*)g.Bt + (size_t)cur.pn * tstep + (size_t)cur.koff * 2;
    S.a_ready(cur);
    if constexpr (SP2) {
        PG8_STAGE(PG8_SB(0, 0), cB, voffB); PG8_STAGE(PG8_SB(0, 1), cB + hstep, voffB); PG8_STAGE(PG8_SA(0, 0), cA, voffA); PG8_STAGE(PG8_SA(0, 1), cA + hstep, voffA);
        if (wr == 1) PG8_BAR;
        PG8_WAIT_V(2); PG8_BAR;
        PG8_STAGE(PG8_SB(1, 0), cB + kstep, voffB); PG8_STAGE(PG8_SA(1, 0), cA + kstep, voffA); PG8_STAGE(PG8_SB(1, 1), cB + hstep + kstep, voffB);
        PG8_WAIT_V(6); PG8_BAR;
    } else {
        PG8_STAGE(PG8_SB(0, 0), cB, voffB); PG8_STAGE(PG8_SA(0, 0), cA, voffA); PG8_STAGE(PG8_SB(0, 1), cB + hstep, voffB); PG8_STAGE(PG8_SA(0, 1), cA + hstep, voffA);
        if (wr == 1) PG8_BAR;
        PG8_WAIT_V(4); PG8_BAR;
        PG8_STAGE(PG8_SB(1, 0), cB + kstep, voffB); PG8_STAGE(PG8_SA(1, 0), cA + kstep, voffA); PG8_STAGE(PG8_SB(1, 1), cB + hstep + kstep, voffB);
        PG8_WAIT_V(6); PG8_BAR;
    }
    for (;;) {
        const bool has_next = S.next(ui + 1, nxt);
        const char* nA = has_next ? (const char*)g.A + (size_t)nxt.pm * tstep + (size_t)nxt.koff * 2 : cA; const char* nB = has_next ? (const char*)g.Bt + (size_t)nxt.pn * tstep + (size_t)nxt.koff * 2 : cB;
        const int nt = cur.nt ? cur.nt : nt_full;
        for (int t = 0; t < nt; t += 2) {
            const bool last = (t == nt - 2);
            const char* a1 = cA + (size_t)(t + 1) * kstep;
            const char* a2 = last ? nA : cA + (size_t)(t + 2) * kstep; const char* b2 = last ? nB : cB + (size_t)(t + 2) * kstep;
            const char* a3 = a2 + kstep; const char* b3 = b2 + kstep;
            if (last && has_next) S.a_ready(nxt);
            if constexpr (SP2) {
            PG8_LDB(B0, 0, 0); PG8_LDB(B1, 0, 1); PG8_SCHED; PG8_LDA(At, 0, 0); PG8_STAGE(PG8_SA(1, 1), a1 + hstep, voffA);
            PG8_WAIT_V(8); PG8_WAIT_L(0); PG8_BAR; PG8_MMA(0, 0, At, B0); PG8_MMA(0, 1, At, B1); PG8_BAR; PG8_SCHED;
            PG8_LDA(At, 0, 1); PG8_STAGE(PG8_SB(0, 0), b2, voffB); PG8_STAGE(PG8_SB(0, 1), b2 + hstep, voffB); PG8_STAGE(PG8_SA(0, 0), a2, voffA);
            PG8_WAIT_V(8); PG8_WAIT_L(0); PG8_BAR; PG8_MMA(1, 0, At, B0); PG8_MMA(1, 1, At, B1); PG8_BAR; PG8_SCHED;
            PG8_LDB(B0, 1, 0); PG8_LDB(B1, 1, 1); PG8_SCHED; PG8_LDA(At, 1, 0); PG8_STAGE(PG8_SA(0, 1), a2 + hstep, voffA);
            PG8_WAIT_V(8); PG8_WAIT_L(0); PG8_BAR; PG8_MMA(0, 0, At, B0); PG8_MMA(0, 1, At, B1); PG8_BAR; PG8_SCHED;
            PG8_LDA(At, 1, 1); PG8_STAGE(PG8_SB(1, 0), b3, voffB); PG8_STAGE(PG8_SB(1, 1), b3 + hstep, voffB); PG8_STAGE(PG8_SA(1, 0), a3, voffA);
            PG8_WAIT_V(8); PG8_WAIT_L(0); PG8_BAR; PG8_MMA(1, 0, At, B0); PG8_MMA(1, 1, At, B1); PG8_BAR; PG8_SCHED;
            } else {
            PG8_LDB(B0, 0, 0); PG8_SCHED; PG8_LDA(At, 0, 0); PG8_STAGE(PG8_SA(1, 1), a1 + hstep, voffA);
            PG8_WAIT_L(8); PG8_BAR; PG8_WAIT_L(0); PG8_MMA(0, 0, At, B0); PG8_BAR; PG8_SCHED;
            PG8_LDB(B1, 0, 1); PG8_STAGE(PG8_SB(0, 0), b2, voffB);
            PG8_BAR; PG8_WAIT_L(0); PG8_MMA(0, 1, At, B1); PG8_BAR;
            PG8_LDA(At, 0, 1); PG8_STAGE(PG8_SA(0, 0), a2, voffA);
            PG8_BAR; PG8_WAIT_L(0); PG8_MMA(1, 0, At, B0); PG8_BAR; PG8_SCHED;
            PG8_STAGE(PG8_SB(0, 1), b2 + hstep, voffB);
            PG8_WAIT_V(6); PG8_BAR; PG8_MMA(1, 1, At, B1); PG8_BAR;
            PG8_LDB(B0, 1, 0); PG8_SCHED; PG8_LDA(At, 1, 0); PG8_STAGE(PG8_SA(0, 1), a2 + hstep, voffA);
            PG8_WAIT_L(8); PG8_BAR; PG8_WAIT_L(0); PG8_MMA(0, 0, At, B0); PG8_BAR; PG8_SCHED;
            PG8_LDB(B1, 1, 1); PG8_STAGE(PG8_SB(1, 0), b3, voffB);
            PG8_BAR; PG8_WAIT_L(0); PG8_MMA(0, 1, At, B1); PG8_BAR;
            PG8_LDA(At, 1, 1); PG8_STAGE(PG8_SA(1, 0), a3, voffA);
            PG8_BAR; PG8_WAIT_L(0); PG8_MMA(1, 0, At, B0); PG8_BAR; PG8_SCHED;
            PG8_STAGE(PG8_SB(1, 1), b3 + hstep, voffB);
            PG8_WAIT_V(6); PG8_BAR; PG8_MMA(1, 1, At, B1); PG8_BAR;
            }
        }
        if constexpr (ALIGN_EPI) { if (wr == 0) PG8_BAR; }
        if constexpr (!Epi::AFTER_DRAIN) { E(acc, cur, wr, wc, fr, fq); S.done(cur); }
        if (!has_next) break;
#pragma unroll
        for (int a = 0; a < 2; ++a)
#pragma unroll
            for (int b = 0; b < 2; ++b)
#pragma unroll
                for (int m = 0; m < 4; ++m)
#pragma unroll
                    for (int n = 0; n < 2; ++n) acc[a][b][m][n] = (f32x4){0.f, 0.f, 0.f, 0.f};
        cur = nxt; cA = nA; cB = nB; ++ui;
        if constexpr (ALIGN_EPI) { if (wr == 1) PG8_BAR; }
    }
    PG8_WAIT_V(0);
    if constexpr (!ALIGN_EPI) { if (wr == 0) PG8_BAR; }
    PG8_BAR;
    if constexpr (Epi::AFTER_DRAIN) { E.fused(acc, cur, wr, wc, fr, fq, lds, wid, lane); S.done(cur); }
#undef PG8_SA
#undef PG8_SB
#undef PG8_STAGE
#undef PG8_LDA
#undef PG8_LDB
#undef PG8_MMA
#undef PG8_WAIT_V
#undef PG8_WAIT_L
#undef PG8_BAR
#undef PG8_SCHED
}
}

#define LAS __attribute__((address_space(3)))
typedef unsigned short bf16_t;
typedef short bf16x8 __attribute__((ext_vector_type(8)));
typedef short s16x4 __attribute__((ext_vector_type(4)));
typedef float f32x4 __attribute__((ext_vector_type(4)));
typedef float f32x16 __attribute__((ext_vector_type(16)));
typedef unsigned u32x4 __attribute__((ext_vector_type(4)));
typedef unsigned u32x2 __attribute__((ext_vector_type(2)));

constexpr int DM = 1024, SEQ = 8192, NBATCH = 2, CTXL = 256, DEPTH = 4, DFF = 4096, INW = 6144;
constexpr int ML = NBATCH * SEQ, MC = NBATCH * CTXL, MT = ML + MC;
constexpr int NKV = SEQ + CTXL;
constexpr int NTHREADS = 512, NWAVES = 8;
constexpr int LDS_BYTES = 147456;
constexpr float C2 = 0.125f * 1.4426950408889634f;
constexpr float LOG2E = 1.4426950408889634f;

constexpr size_t MiB = 1u << 20;
constexpr size_t WS_ROPE = 0;
constexpr size_t WS_BAR = 16384;
constexpr size_t WS_LAM = 32768;
constexpr size_t WS_MOD = 65536;
constexpr size_t WS_WIN = 1 * MiB;
constexpr size_t WS_WBR = WS_WIN + (size_t)INW * DM * 2;
constexpr size_t WS_WOUT = WS_WBR + (size_t)3 * DM * 512 * 2;
constexpr size_t WS_WF1 = WS_WOUT + (size_t)DM * DM * 2;
constexpr size_t WS_WF2 = WS_WF1 + (size_t)DFF * DM * 2;
constexpr size_t WS_Y = 34 * MiB;
constexpr size_t WS_H = 36 * MiB;
constexpr size_t WS_O = 69 * MiB;
constexpr size_t WS_R = 119 * MiB;
constexpr size_t QSZ = (size_t)MT * 512 * 2;
constexpr size_t R_QA = 0, R_QB = QSZ, R_QC = 2 * QSZ, R_KA = 3 * QSZ;
constexpr size_t KSM = (size_t)NBATCH * NKV * 128 * 2;
constexpr size_t R_KB = R_KA + QSZ, R_KC = R_KB + KSM, R_VTA = R_KC + KSM, R_VTB = R_VTA + QSZ, R_VTC = R_VTB + KSM, R_G = R_VTC + KSM;
constexpr size_t R_T12 = 0, R_U = 0, R_T3 = 132 * MiB;
constexpr size_t WS_TCO = WS_R + 198 * MiB;
constexpr size_t WS_TCF = WS_TCO + 16 * MiB;
constexpr size_t WS_SCR = WS_TCF + 16 * MiB;
constexpr size_t WS_END = WS_SCR;
static_assert(WS_WF2 + (size_t)DM * DFF * 2 <= WS_Y, "weights fit");
static_assert(R_G == 99 * MiB, "overlay map");
static_assert(R_G + (size_t)MT * 3072 * 2 == 198 * MiB, "overlay map G");

struct Args { const float* in[23]; float* out; unsigned char* ws; };
enum { I_X = 0, I_C, I_CTX, I_CCTX, I_WADA, I_BADA, I_GPREMIX, I_GPOSTMIX, I_GPREFF, I_GPOSTFF, I_WIN, I_GQ, I_GK, I_LQ1, I_LK1, I_LQ2, I_LK2, I_GSUB, I_SINK, I_WBR, I_WOUT, I_WF1, I_WF2 };

__device__ __forceinline__ const float* inp(int i) { asm volatile("" : "+s"(i)); return ((const float* const*)__builtin_amdgcn_kernarg_segment_ptr())[i]; }
__device__ __forceinline__ float* outp() { return (float*)inp(23); }
__device__ __forceinline__ unsigned char* wsp() { return (unsigned char*)inp(24); }
typedef float f32x2_t __attribute__((ext_vector_type(2))); typedef __bf16 bf16x2_t __attribute__((ext_vector_type(2)));
__device__ __forceinline__ unsigned cvtpk(float lo, float hi) { const f32x2_t v = {lo, hi}; const bf16x2_t b = __builtin_convertvector(v, bf16x2_t); return __builtin_bit_cast(unsigned, b); }
__device__ __forceinline__ float bf_lo(unsigned u) { return __uint_as_float(u << 16); }
__device__ __forceinline__ float bf_hi(unsigned u) { return __uint_as_float(u & 0xffff0000u); }
__device__ __forceinline__ unsigned short f2bf(float f) { return (unsigned short)(cvtpk(f, f) & 0xffffu); }
__device__ __forceinline__ float wave_sum(float v) {
#pragma unroll
    for (int o = 1; o < 64; o <<= 1) v += __shfl_xor(v, o);
    return v;
}
__device__ __forceinline__ int otid() { int t = threadIdx.x; asm volatile("" : "+v"(t)); return t; }
__device__ __forceinline__ int obx() { int b = blockIdx.x; asm volatile("" : "+s"(b)); return b; }
__device__ __forceinline__ float lam_init_of(int l) { return l == 0 ? 0.2f : (l == 1 ? 0.35550906759096926f : (l == 2 ? 0.47071301834358416f : 0.5560582041556405f)); }

struct EpiG1 {
    static constexpr bool PERM = false, AFTER_DRAIN = false;
    unsigned char* R; const float *rope, *gq, *gk;
    __device__ __forceinline__ void operator()(const f32x4 (&acc)[2][2][4][2], const pg8::Unit& u, int wr, int wc, int fr_, int fq_) const {
        int fr = fr_, fq = fq_; asm volatile("" : "+v"(fr), "+v"(fq));
        bf16_t* const QA = (bf16_t*)(R + R_QA); bf16_t* const QB = (bf16_t*)(R + R_QB); bf16_t* const QC = (bf16_t*)(R + R_QC);
        bf16_t* const KA = (bf16_t*)(R + R_KA); bf16_t* const KB = (bf16_t*)(R + R_KB); bf16_t* const KC = (bf16_t*)(R + R_KC);
        bf16_t* const VTA = (bf16_t*)(R + R_VTA); bf16_t* const VTB = (bf16_t*)(R + R_VTB); bf16_t* const VTC = (bf16_t*)(R + R_VTC); bf16_t* const G = (bf16_t*)(R + R_G);
        const int pm = u.pm, pn = u.pn;
        const bool lat = pm < 64;
        const int b = lat ? (pm >> 5) : (pm - 64);
        const int kvb = lat ? ((pm & 31) << 8) : SEQ;
        const int rl0 = wr * 64 + fr;
        if (pn < 9) {
            const int s = pn * 4 + wc;
            bf16_t* dst; int pitch; bool isK = false; float scale = 1.f; const float* gain = nullptr;
            if (s < 8) { dst = QA + s * 64; pitch = 512; scale = C2; }
            else if (s < 16) { dst = KA + (size_t)b * NKV * 512 + (s - 8) * 64; pitch = 512; isK = true; }
            else if (s < 24) { dst = QB + (s - 16) * 64; pitch = 512; scale = C2; gain = gq; }
            else if (s < 32) { dst = QC + (s - 24) * 64; pitch = 512; scale = C2; }
            else if (s < 34) { dst = KB + (size_t)b * NKV * 128 + (s - 32) * 64; pitch = 128; isK = true; gain = gk; }
            else { dst = KC + (size_t)b * NKV * 128 + (s - 34) * 64; pitch = 128; isK = true; }
            const size_t rbase = isK ? (size_t)kvb : (size_t)pm * 256;
#pragma unroll
            for (int ai = 0; ai < 2; ++ai)
#pragma unroll
                for (int m = 0; m < 4; ++m) {
                    const int rl = ai * 128 + rl0 + m * 16;
                    f32x4 v[2][2];
#pragma unroll
                    for (int bj = 0; bj < 2; ++bj)
#pragma unroll
                        for (int n = 0; n < 2; ++n) v[bj][n] = acc[ai][bj][m][n];
                    if (gain) {
                        float ss = 0.f;
#pragma unroll
                        for (int bj = 0; bj < 2; ++bj)
#pragma unroll
                            for (int n = 0; n < 2; ++n) { const f32x4 x = v[bj][n]; ss += (x[0] * x[0] + x[1] * x[1]) + (x[2] * x[2] + x[3] * x[3]); }
                        ss += __shfl_xor(ss, 16); ss += __shfl_xor(ss, 32);
                        const float rstd = rsqrtf(ss * (1.f / 64.f) + 1e-6f);
#pragma unroll
                        for (int bj = 0; bj < 2; ++bj)
#pragma unroll
                            for (int n = 0; n < 2; ++n) { const f32x4 g4 = *(const f32x4*)(gain + 32 * bj + 16 * n + 4 * fq); v[bj][n] = v[bj][n] * rstd * g4; }
                    }
                    if (lat) {
                        const int t = kvb + rl;
#pragma unroll
                        for (int bj = 0; bj < 2; ++bj) {
                            const int pos = bj ? (t & 63) : (t >> 6);
                            const f32x4 cs = *(const f32x4*)(rope + pos * 32 + 4 * fq), sn = *(const f32x4*)(rope + pos * 32 + 16 + 4 * fq);
                            const f32x4 x1 = v[bj][0], x2 = v[bj][1];
                            v[bj][0] = x1 * cs - x2 * sn; v[bj][1] = x2 * cs + x1 * sn;
                        }
                    }
                    bf16_t* rowp = dst + (rbase + rl) * pitch + 4 * fq;
#pragma unroll
                    for (int bj = 0; bj < 2; ++bj)
#pragma unroll
                        for (int n = 0; n < 2; ++n) { const f32x4 x = v[bj][n] * scale; u32x2 w; w.x = cvtpk(x[0], x[1]); w.y = cvtpk(x[2], x[3]); *(u32x2*)(rowp + 32 * bj + 16 * n) = w; }
                }
        } else if (pn < 12) {
#pragma unroll
            for (int bj = 0; bj < 2; ++bj) {
                bf16_t* vt; int vrow0;
                if (pn < 11) { vt = VTA + (size_t)b * 512 * NKV; vrow0 = (pn - 9) * 256 + 128 * bj + 32 * wc + 4 * fq; }
                else { vt = (bj == 0 ? VTB : VTC) + (size_t)b * 128 * NKV; vrow0 = 32 * wc + 4 * fq; }
#pragma unroll
                for (int n = 0; n < 2; ++n)
#pragma unroll
                    for (int j = 0; j < 4; ++j) {
                        bf16_t* colp = vt + (size_t)(vrow0 + 16 * n + j) * NKV + kvb + rl0;
#pragma unroll
                        for (int ai = 0; ai < 2; ++ai)
#pragma unroll
                            for (int m = 0; m < 4; ++m) colp[ai * 128 + m * 16] = f2bf(acc[ai][bj][m][n][j]);
                    }
            }
        } else {
            const int g0 = (pn - 12) * 256 + 32 * wc + 4 * fq;
#pragma unroll
            for (int ai = 0; ai < 2; ++ai)
#pragma unroll
                for (int m = 0; m < 4; ++m) {
                    bf16_t* rowp = G + ((size_t)pm * 256 + ai * 128 + rl0 + m * 16) * 3072 + g0;
#pragma unroll
                    for (int bj = 0; bj < 2; ++bj)
#pragma unroll
                        for (int n = 0; n < 2; ++n) {
                            const f32x4 x = acc[ai][bj][m][n]; f32x4 y;
#pragma unroll
                            for (int j = 0; j < 4; ++j) y[j] = __builtin_amdgcn_rcpf(1.f + __expf(-x[j]));
                            u32x2 w; w.x = cvtpk(y[0], y[1]); w.y = cvtpk(y[2], y[3]); *(u32x2*)(rowp + 128 * bj + 16 * n) = w;
                        }
                }
        }
    }
};

template <int STEP> struct EpiMerge {
    static constexpr bool PERM = true, AFTER_DRAIN = false;
    const bf16_t* G; bf16_t* T; bf16_t* Z;
    __device__ __forceinline__ void operator()(const f32x4 (&acc)[2][2][4][2], const pg8::Unit& u, int wr, int wc, int fr, int fq) const {
        const int row0 = u.pm * 256 + wr * 64 + fr, col0 = u.pn * 256 + wc * 32 + 8 * fq;
#pragma unroll
        for (int ai = 0; ai < 2; ++ai)
#pragma unroll
            for (int m = 0; m < 4; ++m) {
                const size_t r = (size_t)(row0 + ai * 128 + m * 16);
#pragma unroll
                for (int bj = 0; bj < 2; ++bj) {
                    const int c = col0 + 128 * bj;
                    const u32x4 g = *(const u32x4*)(G + r * 3072 + STEP * 1024 + c);
                    f32x4 v0 = acc[ai][bj][m][0], v1 = acc[ai][bj][m][1];
                    v0 = v0 * (f32x4){bf_lo(g.x), bf_hi(g.x), bf_lo(g.y), bf_hi(g.y)};
                    v1 = v1 * (f32x4){bf_lo(g.z), bf_hi(g.z), bf_lo(g.w), bf_hi(g.w)};
                    bf16_t* tp = (STEP < 2 ? T : Z) + r * 1024 + c;
                    if (STEP > 0) { const u32x4 t = *(const u32x4*)(T + r * 1024 + c);
                        v0 = v0 + (f32x4){bf_lo(t.x), bf_hi(t.x), bf_lo(t.y), bf_hi(t.y)}; v1 = v1 + (f32x4){bf_lo(t.z), bf_hi(t.z), bf_lo(t.w), bf_hi(t.w)}; }
                    u32x4 w; w.x = cvtpk(v0[0], v0[1]); w.y = cvtpk(v0[2], v0[3]); w.z = cvtpk(v1[0], v1[1]); w.w = cvtpk(v1[2], v1[3]); *(u32x4*)tp = w;
                }
            }
    }
};
struct EpiF32 {
    static constexpr bool PERM = false, AFTER_DRAIN = false;
    float* T; int ldc;
    __device__ __forceinline__ void operator()(const f32x4 (&acc)[2][2][4][2], const pg8::Unit& u, int wr, int wc, int fr, int fq) const {
        const int row0 = u.pm * 256 + wr * 64 + fr, col0 = u.pn * 256 + wc * 32 + 4 * fq;
#pragma unroll
        for (int ai = 0; ai < 2; ++ai)
#pragma unroll
            for (int m = 0; m < 4; ++m) {
                float* rowp = T + (size_t)(row0 + ai * 128 + m * 16) * ldc + col0;
#pragma unroll
                for (int bj = 0; bj < 2; ++bj)
#pragma unroll
                    for (int n = 0; n < 2; ++n) *(f32x4*)(rowp + 128 * bj + 16 * n) = acc[ai][bj][m][n];
            }
    }
};
struct CtxSplitOrder {
    pg8::StaticOrder S; int G, c, nl, ksplit, klen, npieces;
    __device__ void init(int N, int K, int G_, int c_, bool with_ctx) { S.init(ML, N, G_, c_); G = G_; c = c_; const int nwg = (ML / 256) * (N / 256); nl = c < nwg ? (nwg - c + G - 1) / G : 0;
        ksplit = 8; klen = K / 8; npieces = with_ctx ? (MC / 256) * (N / 256) * ksplit : 0; }
    __device__ bool next(int i, pg8::Unit& u) const {
        if (i < nl) return S.next(i, u);
        const int q = (i - nl) * G + c; if (q >= npieces) return false;
        const int tile = q / ksplit, kc = q % ksplit; u.pm = ML / 256 + (tile >> 2); u.pn = tile & 3; u.koff = kc * klen; u.nt = klen / 64; return true;
    }
    __device__ __forceinline__ void a_ready(const pg8::Unit&) const {}
    __device__ __forceinline__ void done(const pg8::Unit&) const {}
};
struct EpiF32Split {
    static constexpr bool PERM = false, AFTER_DRAIN = false;
    float* T; float* TC; int klen;
    __device__ __forceinline__ void operator()(const f32x4 (&acc)[2][2][4][2], const pg8::Unit& u, int wr, int wc, int fr, int fq) const {
        const int col0 = u.pn * 256 + wc * 32 + 4 * fq;
        if (u.pm < ML / 256) {
            const int row0 = u.pm * 256 + wr * 64 + fr;
#pragma unroll
            for (int ai = 0; ai < 2; ++ai)
#pragma unroll
                for (int m = 0; m < 4; ++m) {
                    float* rowp = T + (size_t)(row0 + ai * 128 + m * 16) * DM + col0;
#pragma unroll
                    for (int bj = 0; bj < 2; ++bj)
#pragma unroll
                        for (int n = 0; n < 2; ++n) *(f32x4*)(rowp + 128 * bj + 16 * n) = acc[ai][bj][m][n];
                }
        } else {
            const int row0 = (u.pm - ML / 256) * 256 + wr * 64 + fr;
#pragma unroll
            for (int ai = 0; ai < 2; ++ai)
#pragma unroll
                for (int m = 0; m < 4; ++m) {
                    float* rowp = TC + ((size_t)(u.koff / klen) * MC + row0 + ai * 128 + m * 16) * DM + col0;
#pragma unroll
                    for (int bj = 0; bj < 2; ++bj)
#pragma unroll
                        for (int n = 0; n < 2; ++n) *(f32x4*)(rowp + 128 * bj + 16 * n) = acc[ai][bj][m][n];
                }
        }
    }
};
struct EpiSqRelu {
    static constexpr bool PERM = true, AFTER_DRAIN = false;
    bf16_t* U; int ldc;
    __device__ __forceinline__ void operator()(const f32x4 (&acc)[2][2][4][2], const pg8::Unit& u, int wr, int wc, int fr, int fq) const {
        const int row0 = u.pm * 256 + wr * 64 + fr, col0 = u.pn * 256 + wc * 32 + 8 * fq;
#pragma unroll
        for (int ai = 0; ai < 2; ++ai)
#pragma unroll
            for (int m = 0; m < 4; ++m) {
                bf16_t* rowp = U + (size_t)(row0 + ai * 128 + m * 16) * ldc + col0;
#pragma unroll
                for (int bj = 0; bj < 2; ++bj) {
                    f32x4 v0 = acc[ai][bj][m][0], v1 = acc[ai][bj][m][1];
#pragma unroll
                    for (int j = 0; j < 4; ++j) { const float a = fmaxf(v0[j], 0.f), c = fmaxf(v1[j], 0.f); v0[j] = a * a; v1[j] = c * c; }
                    u32x4 w; w.x = cvtpk(v0[0], v0[1]); w.y = cvtpk(v0[2], v0[3]); w.z = cvtpk(v1[0], v1[1]); w.w = cvtpk(v1[2], v1[3]);
                    *(u32x4*)(rowp + 128 * bj) = w;
                }
            }
    }
};

constexpr int KP = 72, VP = 72;
constexpr int KBUFB = 64 * KP * 2, VBUFB = 128 * VP * 2, ABUFB = KBUFB + VBUFB;

template <int DV>
__device__ __forceinline__ void attn_pass(f32x16 (&o)[DV / 32], const bf16_t* qrow, const bf16_t* Kb, int kpitch, const bf16_t* Vtb,
                                          int s0a, int s0b, int s1a, int s1b, bool has_sink, float m_init, float l_init, bool win, int qpos, int qw0, LAS unsigned char* lds) {
    const int tid = otid(), lane = tid & 63, r32 = lane & 31, hi = lane >> 5;
    bf16x8 qf[4];
#pragma unroll
    for (int d0 = 0; d0 < 4; ++d0) qf[d0] = *(const bf16x8*)(qrow + 16 * d0 + 8 * hi);
#pragma unroll
    for (int i = 0; i < DV / 32; ++i)
#pragma unroll
        for (int r = 0; r < 16; ++r) o[i][r] = 0.f;
    float mref = has_sink ? m_init : 0.f, lrun = l_init;
    bool first = !has_sink;
    f32x16 negm;
#pragma unroll
    for (int r = 0; r < 16; ++r) negm[r] = -mref;
    const int n0 = (s0b - s0a) >> 6, nt = n0 + ((s1b - s1a) >> 6);
    const int lrow = tid >> 3, lch = tid & 7;
    const bf16_t* kg = Kb + (size_t)lrow * kpitch + lch * 8;
    const bf16_t* vg = Vtb + (size_t)lrow * NKV + lch * 8;
    const int prow = (lrow & ~12) | ((lrow & 4) << 1) | ((lrow & 8) >> 1);
    const unsigned kst = (unsigned)((prow * KP + lch * 8) * 2), vst = (unsigned)(KBUFB + (lrow * VP + lch * 8) * 2);
    u32x4 kr, vr0, vr1;
    {
        const int k0 = (0 < n0) ? s0a : s1a;
        kr = *(const u32x4*)(kg + (size_t)k0 * kpitch); vr0 = *(const u32x4*)(vg + k0);
        if (DV == 128) vr1 = *(const u32x4*)(vg + (size_t)64 * NKV + k0);
        *(LAS u32x4*)(lds + kst) = kr;
        *(LAS u32x4*)(lds + vst) = vr0;
        if (DV == 128) *(LAS u32x4*)(lds + vst + 64 * VP * 2) = vr1;
    }
    asm volatile("" : "+v"(qf[0]), "+v"(qf[1]), "+v"(qf[2]), "+v"(qf[3]));
    __syncthreads();
    for (int t = 0; t < nt; ++t) {
        const int k0 = (t < n0) ? (s0a + (t << 6)) : (s1a + ((t - n0) << 6));
        const bool more = (t + 1 < nt);
        if (more) {
            const int k1 = (t + 1 < n0) ? (s0a + ((t + 1) << 6)) : (s1a + ((t + 1 - n0) << 6));
            kr = *(const u32x4*)(kg + (size_t)k1 * kpitch); vr0 = *(const u32x4*)(vg + k1);
            if (DV == 128) vr1 = *(const u32x4*)(vg + (size_t)64 * NKV + k1);
        }
        const LAS unsigned char* Kl = lds + (t & 1) * ABUFB;
        const LAS unsigned char* Vl = Kl + KBUFB;
        const bool masked = win && (t < n0);
        const bool skip = masked && ((k0 + 63 < qw0 - 128) || (k0 > qw0 + 31 + 128));
        if (!skip) {
            f32x16 p0, p1;
            {
                bf16x8 kf[8];
#pragma unroll
                for (int d0 = 0; d0 < 4; ++d0) {
                    kf[2 * d0] = *(const LAS bf16x8*)(Kl + (r32 * KP + 16 * d0 + 8 * hi) * 2);
                    kf[2 * d0 + 1] = *(const LAS bf16x8*)(Kl + ((32 + r32) * KP + 16 * d0 + 8 * hi) * 2);
                }
                __builtin_amdgcn_sched_barrier(0);
                p0 = __builtin_amdgcn_mfma_f32_32x32x16_bf16(kf[0], qf[0], negm, 0, 0, 0); p1 = __builtin_amdgcn_mfma_f32_32x32x16_bf16(kf[1], qf[0], negm, 0, 0, 0);
#pragma unroll
                for (int d0 = 1; d0 < 4; ++d0) { p0 = __builtin_amdgcn_mfma_f32_32x32x16_bf16(kf[2 * d0], qf[d0], p0, 0, 0, 0); p1 = __builtin_amdgcn_mfma_f32_32x32x16_bf16(kf[2 * d0 + 1], qf[d0], p1, 0, 0, 0); }
                __builtin_amdgcn_sched_barrier(0);
            }
            bf16x8 vfa[8];
#pragma unroll
            for (int db = 0; db < 2; ++db)
#pragma unroll
                for (int c = 0; c < 4; ++c) vfa[db * 4 + c] = *(const LAS bf16x8*)(Vl + ((32 * db + r32) * VP + 16 * c + 8 * hi) * 2);
            if (masked) {
#pragma unroll
                for (int r = 0; r < 16; ++r) {
                    const int kv = k0 + 16 * (r >> 3) + 8 * hi + 4 * ((r >> 2) & 1) + (r & 3);
                    int d0 = kv - qpos; d0 = d0 < 0 ? -d0 : d0; int d1 = kv + 32 - qpos; d1 = d1 < 0 ? -d1 : d1;
                    if (d0 > 128) p0[r] = -1e30f;
                    if (d1 > 128) p1[r] = -1e30f;
                }
            }
#define MX3(a, b, c) __builtin_fmaxf(__builtin_fmaxf((a), (b)), (c))
            float ma = MX3(p0[0], p0[1], p1[0]), mb = MX3(p0[2], p0[3], p1[1]); ma = MX3(ma, p1[2], p1[3]);
#pragma unroll
            for (int r = 4; r < 16; r += 4) { ma = MX3(ma, p0[r], p0[r + 1]); mb = MX3(mb, p0[r + 2], p0[r + 3]); ma = MX3(ma, p1[r], p1[r + 1]); mb = MX3(mb, p1[r + 2], p1[r + 3]); }
#undef MX3
            float mx = fmaxf(ma, mb);
            mx = fmaxf(mx, __shfl_xor(mx, 32));
            if (first || __any(mx > 8.f)) {
                const float dl = first ? mx : fmaxf(mx, 0.f);
                const float alpha = first ? 1.f : __builtin_amdgcn_exp2f(-dl);
                mref += dl; lrun *= alpha;
#pragma unroll
                for (int r = 0; r < 16; ++r) { p0[r] -= dl; p1[r] -= dl; negm[r] = -mref; }
#pragma unroll
                for (int i = 0; i < DV / 32; ++i)
#pragma unroll
                    for (int r = 0; r < 16; ++r) o[i][r] *= alpha;
                first = false;
            }
            float rs0 = 0.f, rs1 = 0.f;
#pragma unroll
            for (int r = 0; r < 16; ++r) { p0[r] = __builtin_amdgcn_exp2f(p0[r]); p1[r] = __builtin_amdgcn_exp2f(p1[r]); rs0 += p0[r]; rs1 += p1[r]; }
            lrun += rs0 + rs1;
            bf16x8 pk[4];
            { u32x4 w;
              w.x = cvtpk(p0[0], p0[1]); w.y = cvtpk(p0[2], p0[3]); w.z = cvtpk(p0[4], p0[5]); w.w = cvtpk(p0[6], p0[7]); pk[0] = __builtin_bit_cast(bf16x8, w);
              w.x = cvtpk(p0[8], p0[9]); w.y = cvtpk(p0[10], p0[11]); w.z = cvtpk(p0[12], p0[13]); w.w = cvtpk(p0[14], p0[15]); pk[1] = __builtin_bit_cast(bf16x8, w);
              w.x = cvtpk(p1[0], p1[1]); w.y = cvtpk(p1[2], p1[3]); w.z = cvtpk(p1[4], p1[5]); w.w = cvtpk(p1[6], p1[7]); pk[2] = __builtin_bit_cast(bf16x8, w);
              w.x = cvtpk(p1[8], p1[9]); w.y = cvtpk(p1[10], p1[11]); w.z = cvtpk(p1[12], p1[13]); w.w = cvtpk(p1[14], p1[15]); pk[3] = __builtin_bit_cast(bf16x8, w); }
            __builtin_amdgcn_sched_barrier(0);
            if (DV == 128) {
                bf16x8 vfb[8];
#pragma unroll
                for (int db = 2; db < 4; ++db)
#pragma unroll
                    for (int c = 0; c < 4; ++c) vfb[(db - 2) * 4 + c] = *(const LAS bf16x8*)(Vl + ((32 * db + r32) * VP + 16 * c + 8 * hi) * 2);
#pragma unroll
                for (int db = 0; db < 2; ++db)
#pragma unroll
                    for (int c = 0; c < 4; ++c) {
                        o[db] = __builtin_amdgcn_mfma_f32_32x32x16_bf16(vfa[db * 4 + c], pk[c], o[db], 0, 0, 0);
                    }
                __builtin_amdgcn_sched_barrier(0);
#pragma unroll
                for (int db = 2; db < DV / 32; ++db)
#pragma unroll
                    for (int c = 0; c < 4; ++c) {
                        o[db] = __builtin_amdgcn_mfma_f32_32x32x16_bf16(vfb[(db - 2) * 4 + c], pk[c], o[db], 0, 0, 0);
                    }
            } else {
#pragma unroll
                for (int db = 0; db < 2; ++db)
#pragma unroll
                    for (int c = 0; c < 4; ++c) {
                        o[db] = __builtin_amdgcn_mfma_f32_32x32x16_bf16(vfa[db * 4 + c], pk[c], o[db], 0, 0, 0);
                    }
            }
            __builtin_amdgcn_sched_barrier(0);
        }
        if (more) {
            const unsigned bo = ((t + 1) & 1) * ABUFB;
            *(LAS u32x4*)(lds + bo + kst) = kr;
            *(LAS u32x4*)(lds + bo + vst) = vr0;
            if (DV == 128) *(LAS u32x4*)(lds + bo + vst + 64 * VP * 2) = vr1;
        }
        __syncthreads();
    }
    const float lt = lrun + __shfl_xor(lrun, 32);
    const float inv = 1.f / lt;
#pragma unroll
    for (int i = 0; i < DV / 32; ++i)
#pragma unroll
        for (int r = 0; r < 16; ++r) o[i][r] *= inv;
}

__device__ __forceinline__ void attn_pass2(f32x16 (&o)[2][2], const bf16_t* qrow0  , const bf16_t* Kb, const bf16_t* Vtb,
                                           int s0a, int s0b, int s1a, int s1b, bool has_sink, float m_init0, float m_init1, float l_init, bool win, int qpos, int qw0, LAS unsigned char* lds) {
    const int tid = otid(), lane = tid & 63, r32 = lane & 31, hi = lane >> 5;
    constexpr int kpitch = 128;
    bf16x8 qf[2][4];
#pragma unroll
    for (int rb = 0; rb < 2; ++rb)
#pragma unroll
        for (int d0 = 0; d0 < 4; ++d0) qf[rb][d0] = *(const bf16x8*)(qrow0 + 64 * rb + 16 * d0 + 8 * hi);
#pragma unroll
    for (int rb = 0; rb < 2; ++rb)
#pragma unroll
        for (int i = 0; i < 2; ++i)
#pragma unroll
            for (int r = 0; r < 16; ++r) o[rb][i][r] = 0.f;
    float mref[2] = {has_sink ? m_init0 : 0.f, has_sink ? m_init1 : 0.f}, lrun[2] = {l_init, l_init};
    bool first = !has_sink;
    const int n0 = (s0b - s0a) >> 6, nt = n0 + ((s1b - s1a) >> 6);
#define LANE_ADDR() const int tl_ = otid(); const int lrow = tl_ >> 3, lch = tl_ & 7; const bf16_t* kg = Kb + (size_t)lrow * kpitch + lch * 8; const bf16_t* vg = Vtb + (size_t)lrow * NKV + lch * 8; \
        const int prow_ = (lrow & ~12) | ((lrow & 4) << 1) | ((lrow & 8) >> 1); \
        const unsigned kst = (unsigned)((prow_ * KP + lch * 8) * 2), vst = (unsigned)(KBUFB + (lrow * VP + lch * 8) * 2)
#define TILE_K0(t) (((t) < n0) ? (s0a + ((t) << 6)) : (s1a + (((t) - n0) << 6)))
    u32x4 kr, vr0;
    { LANE_ADDR(); const int k0 = TILE_K0(0); kr = *(const u32x4*)(kg + (size_t)k0 * kpitch); vr0 = *(const u32x4*)(vg + k0);
      *(LAS u32x4*)(lds + kst) = kr; *(LAS u32x4*)(lds + vst) = vr0; }
    asm volatile("" : "+v"(qf[0][0]), "+v"(qf[0][1]), "+v"(qf[0][2]), "+v"(qf[0][3]), "+v"(qf[1][0]), "+v"(qf[1][1]), "+v"(qf[1][2]), "+v"(qf[1][3]));
    __syncthreads();
    for (int t = 0; t < nt; ++t) {
        const int k0 = TILE_K0(t);
        const bool more = (t + 1 < nt);
        if (more) { LANE_ADDR(); const int k1 = TILE_K0(t + 1); kr = *(const u32x4*)(kg + (size_t)k1 * kpitch); vr0 = *(const u32x4*)(vg + k1); }
        const LAS unsigned char* Kl = lds + (t & 1) * ABUFB;
        const LAS unsigned char* Vl = Kl + KBUFB;
        const bool masked = win && (t < n0);
        const bool skip = masked && ((k0 + 63 < qw0 - 128) || (k0 > qw0 + 31 + 128));
        if (!skip) {
            f32x16 p[2][2];
            {
                const f32x16 z = {0.f, 0.f, 0.f, 0.f, 0.f, 0.f, 0.f, 0.f, 0.f, 0.f, 0.f, 0.f, 0.f, 0.f, 0.f, 0.f};
#pragma unroll
                for (int g = 0; g < 2; ++g) {
                    bf16x8 kf[4];
#pragma unroll
                    for (int d = 0; d < 2; ++d) {
                        kf[2 * d] = *(const LAS bf16x8*)(Kl + (r32 * KP + 16 * (2 * g + d) + 8 * hi) * 2);
                        kf[2 * d + 1] = *(const LAS bf16x8*)(Kl + ((32 + r32) * KP + 16 * (2 * g + d) + 8 * hi) * 2);
                    }
                    __builtin_amdgcn_sched_barrier(0);
#pragma unroll
                    for (int rb = 0; rb < 2; ++rb)
#pragma unroll
                        for (int d = 0; d < 2; ++d) {
                            if (g == 0 && d == 0) { p[rb][0] = __builtin_amdgcn_mfma_f32_32x32x16_bf16(kf[0], qf[rb][0], z, 0, 0, 0); p[rb][1] = __builtin_amdgcn_mfma_f32_32x32x16_bf16(kf[1], qf[rb][0], z, 0, 0, 0); }
                            else { p[rb][0] = __builtin_amdgcn_mfma_f32_32x32x16_bf16(kf[2 * d], qf[rb][2 * g + d], p[rb][0], 0, 0, 0); p[rb][1] = __builtin_amdgcn_mfma_f32_32x32x16_bf16(kf[2 * d + 1], qf[rb][2 * g + d], p[rb][1], 0, 0, 0); }
                        }
                    __builtin_amdgcn_sched_barrier(0);
                }
            }
            bf16x8 pk[2][4];
            const bool domask = masked && !((k0 >= qw0 + 31 - 128) && (k0 + 63 <= qw0 + 128));
            const int ub = k0 - qpos + 128 + 8 * hi;
#define MX3(a, b, c) __builtin_fmaxf(__builtin_fmaxf((a), (b)), (c))
#pragma unroll
            for (int rb = 0; rb < 2; ++rb) {
                f32x16& p0 = p[rb][0]; f32x16& p1 = p[rb][1];
                if (domask) {
#pragma unroll
                    for (int r = 0; r < 16; ++r) { const unsigned u0 = (unsigned)(ub + 16 * (r >> 3) + 4 * ((r >> 2) & 1) + (r & 3)); if (u0 > 256u) p0[r] = -1e30f; if (u0 + 32u > 256u) p1[r] = -1e30f; }
                }
                float ma = MX3(p0[0], p0[1], p1[0]), mb = MX3(p0[2], p0[3], p1[1]); ma = MX3(ma, p1[2], p1[3]);
#pragma unroll
                for (int r = 4; r < 16; r += 4) { ma = MX3(ma, p0[r], p0[r + 1]); mb = MX3(mb, p0[r + 2], p0[r + 3]); ma = MX3(ma, p1[r], p1[r + 1]); mb = MX3(mb, p1[r + 2], p1[r + 3]); }
                float mx = fmaxf(ma, mb);
                mx = fmaxf(mx, __shfl_xor(mx, 32)) - mref[rb];
                if (first || __any(mx > 8.f)) {
                    const float dl = first ? mx : fmaxf(mx, 0.f);
                    const float alpha = first ? 1.f : __builtin_amdgcn_exp2f(-dl);
                    mref[rb] += dl; lrun[rb] *= alpha;
#pragma unroll
                    for (int i = 0; i < 2; ++i)
#pragma unroll
                        for (int r = 0; r < 16; ++r) o[rb][i][r] *= alpha;
                }
                const float mr = mref[rb];
                float rs0 = 0.f, rs1 = 0.f;
#pragma unroll
                for (int r = 0; r < 16; ++r) { p0[r] = __builtin_amdgcn_exp2f(p0[r] - mr); p1[r] = __builtin_amdgcn_exp2f(p1[r] - mr); rs0 += p0[r]; rs1 += p1[r]; }
                lrun[rb] += rs0 + rs1;
                u32x4 w;
                w.x = cvtpk(p0[0], p0[1]); w.y = cvtpk(p0[2], p0[3]); w.z = cvtpk(p0[4], p0[5]); w.w = cvtpk(p0[6], p0[7]); pk[rb][0] = __builtin_bit_cast(bf16x8, w);
                w.x = cvtpk(p0[8], p0[9]); w.y = cvtpk(p0[10], p0[11]); w.z = cvtpk(p0[12], p0[13]); w.w = cvtpk(p0[14], p0[15]); pk[rb][1] = __builtin_bit_cast(bf16x8, w);
                w.x = cvtpk(p1[0], p1[1]); w.y = cvtpk(p1[2], p1[3]); w.z = cvtpk(p1[4], p1[5]); w.w = cvtpk(p1[6], p1[7]); pk[rb][2] = __builtin_bit_cast(bf16x8, w);
                w.x = cvtpk(p1[8], p1[9]); w.y = cvtpk(p1[10], p1[11]); w.z = cvtpk(p1[12], p1[13]); w.w = cvtpk(p1[14], p1[15]); pk[rb][3] = __builtin_bit_cast(bf16x8, w);
            }
#undef MX3
            first = false;
#pragma unroll
            for (int db = 0; db < 2; ++db) {
                bf16x8 vfr[4];
#pragma unroll
                for (int c = 0; c < 4; ++c) vfr[c] = *(const LAS bf16x8*)(Vl + ((32 * db + r32) * VP + 16 * c + 8 * hi) * 2);
#pragma unroll
                for (int c = 0; c < 4; ++c) {
                    const bf16x8 vf = vfr[c];
                    o[0][db] = __builtin_amdgcn_mfma_f32_32x32x16_bf16(vf, pk[0][c], o[0][db], 0, 0, 0);
                    o[1][db] = __builtin_amdgcn_mfma_f32_32x32x16_bf16(vf, pk[1][c], o[1][db], 0, 0, 0);
                }
            }
        }
        if (more) { LANE_ADDR(); const unsigned bo = ((t + 1) & 1) * ABUFB; *(LAS u32x4*)(lds + bo + kst) = kr; *(LAS u32x4*)(lds + bo + vst) = vr0; }
        __syncthreads();
    }
#undef TILE_K0
#undef LANE_ADDR
#pragma unroll
    for (int rb = 0; rb < 2; ++rb) {
        const float lt = lrun[rb] + __shfl_xor(lrun[rb], 32);
        const float inv = 1.f / lt;
#pragma unroll
        for (int i = 0; i < 2; ++i)
#pragma unroll
            for (int r = 0; r < 16; ++r) o[rb][i][r] *= inv;
    }
}

struct AttnPtrs { unsigned char* R; bf16_t* OA; float* scr; const float *gsub, *sink; const float* lamp; int layer; };

__device__ __forceinline__ void attn_phase(const AttnPtrs& P, bool do_ctx, LAS unsigned char* lds) {
    const int NU = 1024 + (do_ctx ? 32 : 0);
    for (int u = obx(); u < NU; u += gridDim.x) {
        const int tid = otid(), lane = tid & 63, r32 = lane & 31, hi = lane >> 5;
        const int wid = __builtin_amdgcn_readfirstlane(tid >> 6);
        int kind, b, h, row0, qp0, s0a, s0b, s1a = SEQ, s1b = SEQ; bool win = false, sinkon = false;
        if (u < 256) { kind = 0; const int bh = u & 7, qb = u >> 3; b = bh >> 2; h = bh & 3; qp0 = qb * 256; row0 = b * SEQ + qp0; s0a = 0; s0b = NKV; }
        else if (u < 1024) {
            kind = (u < 768) ? 1 : 2; int qb;
            if (kind == 1) { const int v = u - 256; const int bh = ((v & 7) << 1) | ((v >> 3) & 1); qb = v >> 4; b = bh >> 3; h = bh & 7; }
            else { const int v = u - 768; const int x = v & 7; qb = v >> 3; b = x >> 2; h = 2 * (x & 3); }
            qp0 = qb * 256; row0 = b * SEQ + qp0;
            if (kind == 1) { s0a = 0; s0b = NKV; }
            else { s0a = qp0 - 128 < 0 ? 0 : qp0 - 128; s0b = qp0 + 384 > SEQ ? SEQ : qp0 + 384; s1a = SEQ; s1b = NKV; win = true; sinkon = true; }
        } else {
            const int w = u - 1024;
            if (w < 8) { kind = 0; b = w >> 2; h = w & 3; }
            else if (w < 24) { kind = 1; b = (w - 8) >> 3; h = (w - 8) & 7; }
            else { kind = 2; b = (w - 24) >> 2; h = 2 * ((w - 24) & 3); sinkon = true; }
            qp0 = 0; row0 = ML + b * CTXL; s0a = SEQ; s0b = NKV;
        }
        const int myrow = row0 + wid * 32 + r32;
        const int qw0 = qp0 + wid * 32, qpos = qw0 + r32;
        if (kind == 0) {
            unsigned o1p[4][8];
#pragma unroll 1
            for (int mp = 0; mp < 2; ++mp) {
                f32x16 o[4];
                attn_pass<128>(o, (const bf16_t*)(P.R + R_QA) + (size_t)myrow * 512 + h * 128 + mp * 64, (const bf16_t*)(P.R + R_KA) + (size_t)b * NKV * 512 + h * 128 + mp * 64, 512,
                               (const bf16_t*)(P.R + R_VTA) + ((size_t)b * 512 + h * 128) * NKV, s0a, s0b, s1a, s1b, false, 0.f, 0.f, false, qpos, qw0, lds);
                if (mp == 0) {
#pragma unroll
                    for (int i = 0; i < 4; ++i)
#pragma unroll
                        for (int k = 0; k < 8; ++k) o1p[i][k] = cvtpk(o[i][2 * k], o[i][2 * k + 1]);
                } else {
                    float ss = 0.f;
                    int ly_ = P.layer; asm volatile("" : "+s"(ly_));
                    const float lam_ = P.lamp[ly_];
#pragma unroll
                    for (int i = 0; i < 4; ++i)
#pragma unroll
                        for (int k = 0; k < 8; ++k) {
                            const float d0 = bf_lo(o1p[i][k]) - lam_ * o[i][2 * k], d1 = bf_hi(o1p[i][k]) - lam_ * o[i][2 * k + 1];
                            o[i][2 * k] = d0; o[i][2 * k + 1] = d1; ss += d0 * d0 + d1 * d1;
                        }
                    ss += __shfl_xor(ss, 32);
                    const float sc = rsqrtf(ss * (1.f / 128.f) + 1e-5f) * (1.f - lam_init_of(ly_));
                    bf16_t* op = P.OA + (size_t)myrow * 512 + h * 128 + 4 * hi;
#pragma unroll
                    for (int i = 0; i < 4; ++i)
#pragma unroll
                        for (int g = 0; g < 4; ++g) {
                            const f32x4 gs = *(const f32x4*)(P.gsub + 32 * i + 8 * g + 4 * hi);
                            u32x2 w; w.x = cvtpk(o[i][4 * g] * sc * gs[0], o[i][4 * g + 1] * sc * gs[1]); w.y = cvtpk(o[i][4 * g + 2] * sc * gs[2], o[i][4 * g + 3] * sc * gs[3]);
                            *(u32x2*)(op + 32 * i + 8 * g) = w;
                        }
                }
            }
        } else {
            const bf16_t* Q = (const bf16_t*)(P.R + (kind == 1 ? R_QB : R_QC)); const bf16_t* K = (const bf16_t*)(P.R + (kind == 1 ? R_KB : R_KC)); const bf16_t* VT = (const bf16_t*)(P.R + (kind == 1 ? R_VTB : R_VTC)); bf16_t* O = P.OA + (size_t)MT * 512 * kind;
            const int kvh = h >> 2;
            if (kind == 1) {
                f32x16 o[2];
                attn_pass<64>(o, Q + (size_t)myrow * 512 + h * 64, K + (size_t)b * NKV * 128 + kvh * 64, 128, VT + ((size_t)b * 128 + kvh * 64) * NKV,
                              s0a, s0b, s1a, s1b, false, 0.f, 0.f, false, qpos, qw0, lds);
                bf16_t* op = O + (size_t)myrow * 512 + h * 64 + 4 * hi;
#pragma unroll
                for (int i = 0; i < 2; ++i)
#pragma unroll
                    for (int g = 0; g < 4; ++g) { u32x2 w; w.x = cvtpk(o[i][4 * g], o[i][4 * g + 1]); w.y = cvtpk(o[i][4 * g + 2], o[i][4 * g + 3]); *(u32x2*)(op + 32 * i + 8 * g) = w; }
            } else {
                const float m0 = P.sink[h] * LOG2E, m1 = P.sink[h + 1] * LOG2E, l0 = hi == 0 ? 1.f : 0.f;
                f32x16 o[2][2];
                attn_pass2(o, Q + (size_t)myrow * 512 + h * 64, K + (size_t)b * NKV * 128 + kvh * 64, VT + ((size_t)b * 128 + kvh * 64) * NKV,
                           s0a, s0b, s1a, s1b, true, m0, m1, l0, win, qpos, qw0, lds);
                const int tid2 = otid();
                bf16_t* op = O + (size_t)(row0 + (tid2 >> 6) * 32 + (tid2 & 31)) * 512 + h * 64 + 4 * ((tid2 & 63) >> 5);
#pragma unroll
                for (int rb = 0; rb < 2; ++rb)
#pragma unroll
                    for (int i = 0; i < 2; ++i)
#pragma unroll
                        for (int g = 0; g < 4; ++g) { u32x2 w; w.x = cvtpk(o[rb][i][4 * g], o[rb][i][4 * g + 1]); w.y = cvtpk(o[rb][i][4 * g + 2], o[rb][i][4 * g + 3]); *(u32x2*)(op + 64 * rb + 32 * i + 8 * g) = w; }
            }
        }
    }
}

__device__ __forceinline__ int nat_col_of(int n) {
    if (n < 2304) {
        const int s = 4 * (n >> 8) + ((n & 127) >> 5), d = 32 * ((n & 255) >> 7) + (n & 31);
        int base;
        if (s < 8) base = 64 * s; else if (s < 16) base = 512 + 64 * (s - 8); else if (s < 24) base = 1536 + 64 * (s - 16);
        else if (s < 32) base = 2304 + 64 * (s - 24); else if (s < 34) base = 2048 + 64 * (s - 32); else base = 2816 + 64 * (s - 34);
        return base + d;
    }
    if (n < 2816) return 1024 + (n - 2304);
    if (n < 2944) return 2176 + (n - 2816);
    return n;
}
__device__ __forceinline__ void transpose_item(const float* W, int K, int N, bf16_t* WT, int nat0, int out0, int k0, LAS float* scr, int lane) {
#pragma unroll 8
    for (int i = 0; i < 32; ++i) { const int kk = 2 * i + (lane >> 5); scr[kk * 33 + (lane & 31)] = W[(size_t)(k0 + kk) * N + nat0 + (lane & 31)]; }
    asm volatile("s_waitcnt lgkmcnt(0)" ::: "memory");
    const int c = lane & 7;
#pragma unroll
    for (int j = 0; j < 4; ++j) { const int n = (lane >> 3) + 8 * j; const LAS float* s = scr + (8 * c) * 33 + n;
        u32x4 o; o.x = cvtpk(s[0 * 33], s[1 * 33]); o.y = cvtpk(s[2 * 33], s[3 * 33]); o.z = cvtpk(s[4 * 33], s[5 * 33]); o.w = cvtpk(s[6 * 33], s[7 * 33]);
        *(u32x4*)(WT + (size_t)(out0 + n) * K + k0 + 8 * c) = o; }
    asm volatile("s_waitcnt lgkmcnt(0)" ::: "memory");
}
__device__ __forceinline__ void convert_weights(const Args& a, int l, LAS unsigned char* lds) {
    const int tid = otid(), lane = tid & 63, wave = tid >> 6;
    LAS float* scr = (LAS float*)(lds + wave * 16384);
    const int gw = obx() * NWAVES + wave, NGW = gridDim.x * NWAVES;
    constexpr int I_IN = 16 * 192, I_BR = 8 * 32, I_OUT = 16 * 32, I_F1 = 16 * 128, I_F2 = 64 * 32;
    constexpr int NIT = I_IN + 3 * I_BR + I_OUT + I_F1 + I_F2;
    bf16_t* w_in_t = (bf16_t*)(wsp() + WS_WIN); bf16_t* w_br_t = (bf16_t*)(wsp() + WS_WBR); bf16_t* w_out_t = (bf16_t*)(wsp() + WS_WOUT);
    bf16_t* w_f1_t = (bf16_t*)(wsp() + WS_WF1); bf16_t* w_f2_t = (bf16_t*)(wsp() + WS_WF2);
    for (int it = gw; it < NIT; it += NGW) {
        int r = it;
        if (r < I_IN) { const int kb = r / 192, nb = r % 192; transpose_item(inp(I_WIN) + (size_t)l * DM * INW, DM, INW, w_in_t, nat_col_of(32 * nb), 32 * nb, 64 * kb, scr, lane); continue; } r -= I_IN;
        if (r < 3 * I_BR) { const int i = r / I_BR, q = r % I_BR, kb = q / 32, nb = q % 32;
            transpose_item(inp(I_WBR) + ((size_t)l * 1536 + i * 512) * DM, 512, DM, w_br_t + (size_t)i * DM * 512, 32 * nb, 32 * nb, 64 * kb, scr, lane); continue; } r -= 3 * I_BR;
        if (r < I_OUT) { const int kb = r / 32, nb = r % 32; transpose_item(inp(I_WOUT) + (size_t)l * DM * DM, DM, DM, w_out_t, 32 * nb, 32 * nb, 64 * kb, scr, lane); continue; } r -= I_OUT;
        if (r < I_F1) { const int kb = r / 128, nb = r % 128; transpose_item(inp(I_WF1) + (size_t)l * DM * DFF, DM, DFF, w_f1_t, 32 * nb, 32 * nb, 64 * kb, scr, lane); continue; } r -= I_F1;
        { const int kb = r / 32, nb = r % 32; transpose_item(inp(I_WF2) + (size_t)l * DFF * DM, DFF, DM, w_f2_t, 32 * nb, 32 * nb, 64 * kb, scr, lane); }
    }
}
__device__ __forceinline__ float silu_f(float x) { return x / (1.f + __expf(-x)); }

__device__ __forceinline__ void prologue_small(const Args& a, LAS unsigned char* lds) {
    const int tid = otid();
    if (obx() == 0) {
        float* rope = (float*)(wsp() + WS_ROPE);
        for (int e = tid; e < 128 * 16; e += NTHREADS) {
            const int pos = e >> 4, i = e & 15;
            const float invf = exp2f(-(float)i * (13.287712379549449f / 16.f));
            const float ang = (float)pos * invf;
            const float k = rintf(ang * 0.15915494309189535f);
            float r = fmaf(-k, 6.2831854820251465f, ang); r = fmaf(-k, -1.7484555e-7f, r);
            rope[pos * 32 + i] = __cosf(r); rope[pos * 32 + 16 + i] = __sinf(r);
        }
        if (tid < 256) {
            const int l = tid >> 6, i = tid & 63;
            const float s1 = wave_sum(inp(I_LQ1)[l * 64 + i] * inp(I_LK1)[l * 64 + i]);
            const float s2 = wave_sum(inp(I_LQ2)[l * 64 + i] * inp(I_LK2)[l * 64 + i]);
            if (i == 0) ((float*)(wsp() + WS_LAM))[l] = expf(s1) - expf(s2) + lam_init_of(l);
        }
    }
    LAS float* sv = (LAS float*)lds;
    LAS float* red = (LAS float*)(lds + 12288);
    for (int e = tid; e < 3 * 1024; e += NTHREADS) { const int v = e >> 10, k = e & 1023; sv[e] = silu_f(v < 2 ? inp(I_C)[v * 1024 + k] : inp(I_CCTX)[k]); }
    __syncthreads();
    float* mod = (float*)(wsp() + WS_MOD);
    const int col4 = (tid & 31) * 4, ks = tid >> 5;
    for (int item = obx(); item < 4 * 48; item += gridDim.x) {
        const int l = item / 48, n0 = (item % 48) * 128;
        f32x4 a0 = {0.f, 0.f, 0.f, 0.f}, a1 = a0, a2 = a0;
        const float* wp = inp(I_WADA) + ((size_t)l * 1024 + ks * 64) * INW + n0 + col4;
#pragma unroll 4
        for (int kk = 0; kk < 64; ++kk) {
            const f32x4 w = *(const f32x4*)(wp + (size_t)kk * INW); const int k = ks * 64 + kk;
            a0 = a0 + w * sv[k]; a1 = a1 + w * sv[1024 + k]; a2 = a2 + w * sv[2048 + k];
        }
        *(LAS f32x4*)(red + (ks * 3 + 0) * 128 + col4) = a0; *(LAS f32x4*)(red + (ks * 3 + 1) * 128 + col4) = a1; *(LAS f32x4*)(red + (ks * 3 + 2) * 128 + col4) = a2;
        __syncthreads();
        if (tid < 384) {
            const int v = tid >> 7, cidx = tid & 127; float s = inp(I_BADA)[l * INW + n0 + cidx];
#pragma unroll
            for (int q = 0; q < 16; ++q) s += red[(q * 3 + v) * 128 + cidx];
            mod[((size_t)l * 3 + v) * INW + n0 + cidx] = s;
        }
        __syncthreads();
    }
}

__device__ __forceinline__ void row_phase(const Args& a, const float* T, const float* Tc  , float* zc  , const float* modT  , int gm_off, const float* gpost,
                                          const float* modH  , int sh_off, int sc_off, const float* gpre, bool init, bool wrH, int nrows) {
    const int tid = otid(), lane = tid & 63, wave = tid >> 6;
    const int gw = obx() * NWAVES + wave, NGW = gridDim.x * NWAVES;
    float* Y = (float*)(wsp() + WS_Y); bf16_t* H = (bf16_t*)(wsp() + WS_H);
    for (int r = gw; r < nrows; r += NGW) {
        const int mi = r < SEQ ? 0 : (r < ML ? 1 : 2);
        float* xrow = r < ML ? outp() + (size_t)r * DM : Y + (size_t)(r - ML) * DM;
        const float* src = init ? (r < ML ? inp(I_X) + (size_t)r * DM : inp(I_CTX) + (size_t)(r - ML) * DM) : xrow;
        f32x4 x[4];
#pragma unroll
        for (int j = 0; j < 4; ++j) x[j] = *(const f32x4*)(src + 256 * j + 4 * lane);
        if (T) {
            f32x4 t[4]; float ss = 0.f;
            const float* trow = r < ML ? T + (size_t)r * DM : Tc + (size_t)(r - ML) * DM;
#pragma unroll
            for (int j = 0; j < 4; ++j) { t[j] = *(const f32x4*)(trow + 256 * j + 4 * lane);
                if (r >= ML) {
#pragma unroll
                    for (int s = 1; s < 8; ++s) t[j] = t[j] + *(const f32x4*)(trow + (size_t)s * MC * DM + 256 * j + 4 * lane);
                } ss += (t[j][0] * t[j][0] + t[j][1] * t[j][1]) + (t[j][2] * t[j][2] + t[j][3] * t[j][3]); }
            const float rstd = rsqrtf(wave_sum(ss) * (1.f / DM) + 1e-6f);
            const float* gm = modT + (size_t)mi * INW + gm_off;
#pragma unroll
            for (int j = 0; j < 4; ++j) { const int c = 256 * j + 4 * lane; const f32x4 g = *(const f32x4*)(gm + c), gp = *(const f32x4*)(gpost + c); x[j] = x[j] + g * (t[j] * rstd * gp); }
        }
        if (T || init) {
#pragma unroll
            for (int j = 0; j < 4; ++j) *(f32x4*)(xrow + 256 * j + 4 * lane) = x[j];
        }
        if (wrH) {
            float ss = 0.f;
#pragma unroll
            for (int j = 0; j < 4; ++j) ss += (x[j][0] * x[j][0] + x[j][1] * x[j][1]) + (x[j][2] * x[j][2] + x[j][3] * x[j][3]);
            const float rstd = rsqrtf(wave_sum(ss) * (1.f / DM) + 1e-6f);
            const float* sh = modH + (size_t)mi * INW + sh_off; const float* sc = modH + (size_t)mi * INW + sc_off;
#pragma unroll
            for (int j = 0; j < 4; ++j) { const int c = 256 * j + 4 * lane; const f32x4 gp = *(const f32x4*)(gpre + c), s1 = *(const f32x4*)(sc + c), s0 = *(const f32x4*)(sh + c);
                const f32x4 hv = (x[j] * rstd * gp) * (1.f + s1) + s0; u32x2 w; w.x = cvtpk(hv[0], hv[1]); w.y = cvtpk(hv[2], hv[3]); *(u32x2*)(H + (size_t)r * DM + c) = w; }
        }
    }
}

#define XB_TMO      128
#define XB_XCNT(j)  (256  + 64 * (j))
#define XB_XSUB(j)  (1280 + 64 * (j))
#define XB_XGEN(j)  (2304 + 64 * (j))
#define XB_TOP      3328
#define XB_TOPGEN   3392
#define XCD_BAR_WORDS 3456
#define XB_SPIN_CAP (1u << 20)

__device__ __forceinline__ unsigned xb_ld(unsigned* p)              { return __hip_atomic_load(p, __ATOMIC_RELAXED, __HIP_MEMORY_SCOPE_AGENT); }
__device__ __forceinline__ unsigned xb_add(unsigned* p, unsigned v) { return __hip_atomic_fetch_add(p, v, __ATOMIC_RELAXED, __HIP_MEMORY_SCOPE_AGENT); }
__device__ __forceinline__ unsigned xb_xcc_id() { return (unsigned)__builtin_amdgcn_s_getreg((3 << 11) | 20) & 0xFu; }
#define XB_SPIN(cond, bar) do { unsigned _sp = 0; while (cond) { __builtin_amdgcn_s_sleep(1); \
    if ((++_sp & 255u) == 0u) { if (xb_ld(&(bar)[XB_TMO])) break; if (_sp > XB_SPIN_CAP) { atomicAdd(&(bar)[XB_TMO], 1u); break; } } } } while (0)

struct XcdBarrier {
    unsigned* bar; unsigned x;
    volatile LAS unsigned* st;
};

__device__ __forceinline__ XcdBarrier xcd_barrier_post(unsigned* bar, volatile LAS unsigned* st) {
    XcdBarrier b; b.bar = bar; b.x = xb_xcc_id(); b.st = st;
    if (threadIdx.x == 0) (void)xb_add(&bar[XB_XCNT(b.x)], 1u);
    return b;
}
__device__ __forceinline__ void xcd_barrier_complete(unsigned* bar, unsigned x, unsigned& nloc, unsigned& nx) {
    const unsigned G = gridDim.x * gridDim.y * gridDim.z;
    unsigned sum, cnt, mine, sp = 0u;
    for (;;) {
        sum = 0u; cnt = 0u; mine = 0u;
#pragma unroll
        for (unsigned j = 0; j < 16; ++j) { const unsigned c = xb_ld(&bar[XB_XCNT(j)]); sum += c; cnt += (c > 0u) ? 1u : 0u; mine = (j == x) ? c : mine; }
        if (sum == G) break;
        __builtin_amdgcn_s_sleep(1);
        if ((++sp & 255u) == 0u) { if (xb_ld(&bar[XB_TMO])) break; if (sp > XB_SPIN_CAP) { atomicAdd(&bar[XB_TMO], 1u); break; } }
    }
    nloc = mine > 0u ? mine : 1u; nx = cnt > 0u ? cnt : 1u;
}

__device__ __forceinline__ void xcd_barrier(const XcdBarrier& b) {
    asm volatile("s_waitcnt vmcnt(0)" ::: "memory");
    __syncthreads();
    if (threadIdx.x == 0) {
        unsigned* bar = b.bar;
        __builtin_amdgcn_s_waitcnt(0);
        unsigned nloc = b.st[0], nx = b.st[1];
        if (nloc == 0u) { xcd_barrier_complete(bar, b.x, nloc, nx); b.st[0] = nloc; b.st[1] = nx; }
        const unsigned old = xb_add(&bar[XB_XSUB(b.x)], 1u);
        const unsigned gen = old / nloc;
        if (old + 1u == (gen + 1u) * nloc) {
            __builtin_amdgcn_fence(__ATOMIC_RELEASE, "agent");
            asm volatile("s_waitcnt vmcnt(0)" ::: "memory");
            const unsigned og = xb_add(&bar[XB_TOP], 1u);
            const unsigned tg = og / nx;
            if (og + 1u == (tg + 1u) * nx) xb_add(&bar[XB_TOPGEN], 1u);
            else XB_SPIN(xb_ld(&bar[XB_TOPGEN]) == tg, bar);
            __builtin_amdgcn_fence(__ATOMIC_ACQUIRE, "agent");
            xb_add(&bar[XB_XGEN(b.x)], 1u);
            asm volatile("s_waitcnt vmcnt(0)" ::: "memory");
        } else {
            XB_SPIN(xb_ld(&bar[XB_XGEN(b.x)]) == gen, bar);
            __builtin_amdgcn_fence(__ATOMIC_ACQUIRE, "agent");
            asm volatile("s_waitcnt vmcnt(0)" ::: "memory");
        }
    }
    __syncthreads();
}

__global__ void __launch_bounds__(NTHREADS) mega_fwd(Args a) {
    extern __shared__ __attribute__((aligned(16))) unsigned char lds_raw[];
    LAS unsigned char* lds = (LAS unsigned char*)lds_raw;
    cg::grid_group grid = cg::this_grid();
    volatile LAS unsigned* xst = (volatile LAS unsigned*)(lds + 131328);
    if (otid() == 0) { xst[0] = 0u; xst[1] = 0u; }
    __syncthreads();
    (void)xcd_barrier_post((unsigned*)(wsp() + WS_BAR), xst);
#define GSYNC() do { XcdBarrier b_; b_.bar = (unsigned*)(wsp() + WS_BAR); b_.x = xb_xcc_id(); b_.st = xst; xcd_barrier(b_); } while (0)
#define WSP(T, off) ((T*)(wsp() + (off)))
#define MODL(l) (WSP(const float, WS_MOD) + (size_t)(l) * 3 * INW)
    prologue_small(a, lds);
    convert_weights(a, 0, lds);
    grid.sync();
    row_phase(a, nullptr, nullptr, WSP(float, WS_TCO), MODL(0), 0, nullptr, MODL(0), 0, 1024, inp(I_GPREMIX), true, true, MT);
    GSYNC();

#pragma unroll 1
    for (int l = 0; l < DEPTH; ++l) {
        const int MR = (l < DEPTH - 1) ? MT : ML;
#ifndef NO_G1
        { pg8::Gemm g{WSP(bf16_t, WS_H), WSP(bf16_t, WS_WIN), MT, INW, DM}; pg8::StaticOrder S; S.init(MT, INW, (int)gridDim.x, obx());
          EpiG1 E{wsp() + WS_R, WSP(const float, WS_ROPE), inp(I_GQ) + l * 64, inp(I_GK) + l * 64};
          pg8::gemm_phase<EpiG1, pg8::StaticOrder, true, true>(lds, g, S, E); }
#endif
        GSYNC();
#ifndef NO_ATT
        { AttnPtrs P{wsp() + WS_R, WSP(bf16_t, WS_O), WSP(float, WS_SCR), inp(I_GSUB) + l * 128, inp(I_SINK) + l * 8, WSP(const float, WS_LAM), l};
          attn_phase(P, l < DEPTH - 1, lds); }
#endif
        GSYNC();
#ifndef NO_MRG
        { pg8::StaticOrder S; S.init(MR, DM, (int)gridDim.x, obx());
          { pg8::Gemm g{WSP(bf16_t, WS_O), WSP(bf16_t, WS_WBR), MR, DM, 512}; EpiMerge<0> E{WSP(bf16_t, WS_R + R_G), WSP(bf16_t, WS_R + R_T12), WSP(bf16_t, WS_H)};
            pg8::gemm_phase<EpiMerge<0>, pg8::StaticOrder, true, true>(lds, g, S, E); }
          { pg8::Gemm g{WSP(bf16_t, WS_O) + (size_t)MT * 512, WSP(bf16_t, WS_WBR) + (size_t)DM * 512, MR, DM, 512}; EpiMerge<1> E{WSP(bf16_t, WS_R + R_G), WSP(bf16_t, WS_R + R_T12), WSP(bf16_t, WS_H)};
            pg8::gemm_phase<EpiMerge<1>, pg8::StaticOrder, true, true>(lds, g, S, E); }
          { pg8::Gemm g{WSP(bf16_t, WS_O) + (size_t)2 * MT * 512, WSP(bf16_t, WS_WBR) + (size_t)2 * DM * 512, MR, DM, 512}; EpiMerge<2> E{WSP(bf16_t, WS_R + R_G), WSP(bf16_t, WS_R + R_T12), WSP(bf16_t, WS_H)};
            pg8::gemm_phase<EpiMerge<2>, pg8::StaticOrder, true, true>(lds, g, S, E); } }
#endif
        GSYNC();
#ifndef NO_OUT
        { pg8::Gemm g{WSP(bf16_t, WS_H), WSP(bf16_t, WS_WOUT), MR, DM, DM}; CtxSplitOrder S; S.init(DM, DM, (int)gridDim.x, obx(), l < DEPTH - 1); EpiF32Split E{WSP(float, WS_R + R_T12), WSP(float, WS_TCO), DM / 8};
          pg8::gemm_phase<EpiF32Split, CtxSplitOrder, true, true>(lds, g, S, E); }
#endif
        GSYNC();
        row_phase(a, WSP(const float, WS_R + R_T12), WSP(const float, WS_TCO), WSP(float, WS_TCF), MODL(l), 2048, inp(I_GPOSTMIX) + l * DM, MODL(l), 3072, 4096, inp(I_GPREFF) + l * DM, false, true, MR);
        GSYNC();
#ifndef NO_FFN
        { pg8::Gemm g{WSP(bf16_t, WS_H), WSP(bf16_t, WS_WF1), MR, DFF, DM}; pg8::StaticOrder S; S.init(MR, DFF, (int)gridDim.x, obx()); EpiSqRelu E{WSP(bf16_t, WS_R + R_U), DFF};
          pg8::gemm_phase<EpiSqRelu, pg8::StaticOrder, true, true>(lds, g, S, E); }
        GSYNC();
        { pg8::Gemm g{WSP(bf16_t, WS_R + R_U), WSP(bf16_t, WS_WF2), MR, DM, DFF}; CtxSplitOrder S; S.init(DM, DFF, (int)gridDim.x, obx(), l < DEPTH - 1); EpiF32Split E{WSP(float, WS_R + R_T3), WSP(float, WS_TCF), DFF / 8};
          pg8::gemm_phase<EpiF32Split, CtxSplitOrder, true, true>(lds, g, S, E); }
#endif
        GSYNC();
        if (l < DEPTH - 1) {
            row_phase(a, WSP(const float, WS_R + R_T3), WSP(const float, WS_TCF), WSP(float, WS_TCO), MODL(l), 5120, inp(I_GPOSTFF) + l * DM, MODL(l + 1), 0, 1024, inp(I_GPREMIX) + (l + 1) * DM, false, true, MT);
            convert_weights(a, l + 1, lds);
            GSYNC();
        } else {
            row_phase(a, WSP(const float, WS_R + R_T3), WSP(const float, WS_TCF), nullptr, MODL(l), 5120, inp(I_GPOSTFF) + l * DM, MODL(l), 0, 1024, inp(I_GPREMIX), false, false, ML);
        }
    }
}

extern "C" void kernel_launch(void* const* d_in, const int* in_sizes, int n_in, void* d_out, int out_size, void* d_ws, size_t ws_size, hipStream_t stream) {
    static int grid = 0;
    if (grid == 0) {
        if (n_in != 23 || ws_size < WS_END) { fprintf(stderr, "kernel_launch: unexpected n_in %d / ws %zu (need %zu)\n", n_in, ws_size, (size_t)WS_END); grid = -1; return; }
        int dev = 0, cus = 0, per_cu = 0;
        hipGetDevice(&dev);
        hipDeviceGetAttribute(&cus, hipDeviceAttributeMultiprocessorCount, dev);
        if (hipFuncSetAttribute((const void*)mega_fwd, hipFuncAttributeMaxDynamicSharedMemorySize, LDS_BYTES) != hipSuccess) { fprintf(stderr, "kernel_launch: hipFuncSetAttribute failed\n"); }
        if (hipOccupancyMaxActiveBlocksPerMultiprocessor(&per_cu, (const void*)mega_fwd, NTHREADS, LDS_BYTES) != hipSuccess || per_cu < 1) per_cu = 1;
        (void)hipGetLastError();
        grid = cus * per_cu;
    }
    if (grid < 0) return;
    Args a{};
    for (int i = 0; i < 23; ++i) a.in[i] = (const float*)d_in[i];
    a.out = (float*)d_out; a.ws = (unsigned char*)d_ws;
    (void)hipMemsetAsync((char*)d_ws + WS_BAR, 0, 16384, stream);
    void* args[] = {&a};
    hipError_t e = hipLaunchCooperativeKernel((const void*)mega_fwd, dim3(grid), dim3(NTHREADS), args, LDS_BYTES, stream);
    if (e != hipSuccess) fprintf(stderr, "cooperative launch failed: %s (grid %d)\n", hipGetErrorString(e), grid);
}
```

```cpp
#include <hip/hip_runtime.h>
#include <hip/hip_cooperative_groups.h>
#include <cstdio>
#include <cstdint>
namespace cg = cooperative_groups;
namespace pg8 {
#define PG8_LAS __attribute__((address_space(3)))
typedef unsigned short bf16_t;
typedef short bf16x8 __attribute__((ext_vector_type(8)));
typedef float f32x4 __attribute__((ext_vector_type(4)));
typedef unsigned u32x4 __attribute__((ext_vector_type(4)));
constexpr int BM = 256, BK = 64, HALF = 128, HTB = HALF * BK * 2  , STAGE_BYTES = 8 * HTB, NXCD = 8, WGM = 8;

__host__ __device__ __forceinline__ int lds_byte(int r, int c) { const int st = (r >> 4) * 2 + (c >> 5), rr = r & 15, cc = c & 31, ob = rr * 64 + cc * 2; return st * 1024 + (ob ^ (((ob >> 9) & 1) << 5)); }
__host__ __device__ __forceinline__ void stage_rc(int b, int& R, int& C) { const int st = b / 1024, sb = b % 1024, swz = sb ^ (((sb >> 9) & 1) << 5); R = (st >> 1) * 16 + swz / 64; C = (st & 1) * 32 + (swz % 64) / 2; }
__host__ __device__ __forceinline__ int perm32(int rho) { const int n = rho >> 4, i = rho & 15; return 8 * (i >> 2) + 4 * n + (i & 3); }

struct Unit { int pm, pn, koff, nt; };
struct Gemm { const bf16_t* A; const bf16_t* Bt; int M, N, K; };

struct StaticOrder {
    int nM, nN, nwg, G, c;
    __host__ __device__ void init(int M, int N, int G_, int c_) { nM = M / BM; nN = N / BM; nwg = nM * nN; G = G_; c = c_; }
    __host__ __device__ bool next(int i, Unit& u) const {
        const long L = (long)i * G + c; if (L >= nwg) return false;
        int wgid = (int)L; { const int q = nwg / NXCD, r = nwg % NXCD, xcd = wgid % NXCD, off = wgid / NXCD; wgid = (xcd < r ? xcd * (q + 1) : r * (q + 1) + (xcd - r) * q) + off; }
        const int nig = WGM * nN, gid = wgid / nig, fm = gid * WGM, gsz = (nM - fm) < WGM ? (nM - fm) : WGM;
        u.pm = fm + ((wgid % nig) % gsz); u.pn = (wgid % nig) / gsz; u.koff = 0; u.nt = 0; return true;
    }
    __device__ __forceinline__ void a_ready(const Unit&) const {}
    __device__ __forceinline__ void done(const Unit&) const {}
};

template <class Epi, class Sched, bool ALIGN_EPI = false, bool SP2 = false>
__device__ __forceinline__ void gemm_phase(PG8_LAS unsigned char* lds, const Gemm g, const Sched& S, const Epi& E) {
    int tid_ = threadIdx.x; asm volatile("" : "+v"(tid_)); const int tid = tid_, wid = __builtin_amdgcn_readfirstlane(tid >> 6), lane = tid & 63, wr = wid >> 2, wc = wid & 3, fr = lane & 15, fq = lane >> 4;
    const int K = g.K, nt_full = K / BK;
    unsigned voffA[2], voffB[2];
#pragma unroll
    for (int i = 0; i < 2; ++i) { int R, C; stage_rc(tid * 16 + i * 8192, R, C); const int Rb = Epi::PERM ? ((R & ~31) + perm32(R & 31)) : R;
        voffA[i] = (unsigned)(R * K + C) * 2u; voffB[i] = (unsigned)(Rb * K + C) * 2u; }
    const size_t kstep = (size_t)(BK * 2);
    const size_t hstep = (size_t)HALF * K * 2;
    const size_t tstep = 2 * hstep;
    const unsigned ldsw = (unsigned)wid * 1024u;
    const int aoff = lds_byte(wr * 64 + fr, fq * 8), boff = lds_byte(wc * 32 + fr, fq * 8);
#define PG8_SA(b, h) (((b) * 2 + (h)) * HTB)
#define PG8_SB(b, h) ((4 + (b) * 2 + (h)) * HTB)
#define PG8_STAGE(bufoff, gbase, voff) do { _Pragma("unroll") for (int _i = 0; _i < 2; ++_i) \
        __builtin_amdgcn_global_load_lds((const unsigned*)((const char*)(gbase) + (voff)[_i]), (PG8_LAS unsigned*)(lds + (bufoff) + ldsw + _i * 8192), 16, 0, 0); } while (0)
#define PG8_LDA(dst, b, h) do { _Pragma("unroll") for (int m = 0; m < 4; ++m) _Pragma("unroll") for (int k = 0; k < 2; ++k) dst[m][k] = *(const PG8_LAS bf16x8*)(lds + PG8_SA(b, h) + aoff + m * 2048 + k * 1024); } while (0)
#define PG8_LDB(dst, b, h) do { _Pragma("unroll") for (int n = 0; n < 2; ++n) _Pragma("unroll") for (int k = 0; k < 2; ++k) dst[n][k] = *(const PG8_LAS bf16x8*)(lds + PG8_SB(b, h) + boff + n * 2048 + k * 1024); } while (0)
#define PG8_MMA(ai, bj, At, Bt) do { __builtin_amdgcn_s_setprio(1); _Pragma("unroll") for (int m = 0; m < 4; ++m) _Pragma("unroll") for (int n = 0; n < 2; ++n) _Pragma("unroll") for (int k = 0; k < 2; ++k) \
        acc[ai][bj][m][n] = __builtin_amdgcn_mfma_f32_16x16x32_bf16(Bt[n][k], At[m][k], acc[ai][bj][m][n], 0, 0, 0); __builtin_amdgcn_s_setprio(0); } while (0)
#define PG8_WAIT_V(n) asm volatile("s_waitcnt vmcnt(" #n ")" ::: "memory")
#define PG8_WAIT_L(n) asm volatile("s_waitcnt lgkmcnt(" #n ")" ::: "memory")
#define PG8_BAR __builtin_amdgcn_s_barrier()
#define PG8_SCHED __builtin_amdgcn_sched_barrier(0)
    Unit cur, nxt; int ui = 0;
    if (!S.next(0, cur)) return;
    f32x4 acc[2][2][4][2];
#pragma unroll
    for (int a = 0; a < 2; ++a)
#pragma unroll
        for (int b = 0; b < 2; ++b)
#pragma unroll
            for (int m = 0; m < 4; ++m)
#pragma unroll
                for (int n = 0; n < 2; ++n) acc[a][b][m][n] = (f32x4){0.f, 0.f, 0.f, 0.f};
    bf16x8 At[4][2], B0[2][2], B1[2][2];
    const char* cA = (const char*)g.A + (size_t)cur.pm * tstep + (size_t)cur.koff * 2; const char* cB = (const char*)g.Bt + (size_t)cur.pn * tstep + (size_t)cur.koff * 2;
    S.a_ready(cur);
    if constexpr (SP2) {
        PG8_STAGE(PG8_SB(0, 0), cB, voffB); PG8_STAGE(PG8_SB(0, 1), cB + hstep, voffB); PG8_STAGE(PG8_SA(0, 0), cA, voffA); PG8_STAGE(PG8_SA(0, 1), cA + hstep, voffA);
        if (wr == 1) PG8_BAR;
        PG8_WAIT_V(2); PG8_BAR;
        PG8_STAGE(PG8_SB(1, 0), cB + kstep, voffB); PG8_STAGE(PG8_SA(1, 0), cA + kstep, voffA); PG8_STAGE(PG8_SB(1, 1), cB + hstep + kstep, voffB);
        PG8_WAIT_V(6); PG8_BAR;
    } else {
        PG8_STAGE(PG8_SB(0, 0), cB, voffB); PG8_STAGE(PG8_SA(0, 0), cA, voffA); PG8_STAGE(PG8_SB(0, 1), cB + hstep, voffB); PG8_STAGE(PG8_SA(0, 1), cA + hstep, voffA);
        if (wr == 1) PG8_BAR;
        PG8_WAIT_V(4); PG8_BAR;
        PG8_STAGE(PG8_SB(1, 0), cB + kstep, voffB); PG8_STAGE(PG8_SA(1, 0), cA + kstep, voffA); PG8_STAGE(PG8_SB(1, 1), cB + hstep + kstep, voffB);
        PG8_WAIT_V(6); PG8_BAR;
    }
    for (;;) {
        const bool has_next = S.next(ui + 1, nxt);
        const char* nA = has_next ? (const char*)g.A + (size_t)nxt.pm * tstep + (size_t)nxt.koff * 2 : cA; const char* nB = has_next ? (const char*)g.Bt + (size_t)nxt.pn * tstep + (size_t)nxt.koff * 2 : cB;
        const int nt = cur.nt ? cur.nt : nt_full;
        for (int t = 0; t < nt; t += 2) {
            const bool last = (t == nt - 2);
            const char* a1 = cA + (size_t)(t + 1) * kstep;
            const char* a2 = last ? nA : cA + (size_t)(t + 2) * kstep; const char* b2 = last ? nB : cB + (size_t)(t + 2) * kstep;
            const char* a3 = a2 + kstep; const char* b3 = b2 + kstep;
            if (last && has_next) S.a_ready(nxt);
            if constexpr (SP2) {
            PG8_LDB(B0, 0, 0); PG8_LDB(B1, 0, 1); PG8_SCHED; PG8_LDA(At, 0, 0); PG8_STAGE(PG8_SA(1, 1), a1 + hstep, voffA);
            PG8_WAIT_V(8); PG8_WAIT_L(0); PG8_BAR; PG8_MMA(0, 0, At, B0); PG8_MMA(0, 1, At, B1); PG8_BAR; PG8_SCHED;
            PG8_LDA(At, 0, 1); PG8_STAGE(PG8_SB(0, 0), b2, voffB); PG8_STAGE(PG8_SB(0, 1), b2 + hstep, voffB); PG8_STAGE(PG8_SA(0, 0), a2, voffA);
            PG8_WAIT_V(8); PG8_WAIT_L(0); PG8_BAR; PG8_MMA(1, 0, At, B0); PG8_MMA(1, 1, At, B1); PG8_BAR; PG8_SCHED;
            PG8_LDB(B0, 1, 0); PG8_LDB(B1, 1, 1); PG8_SCHED; PG8_LDA(At, 1, 0); PG8_STAGE(PG8_SA(0, 1), a2 + hstep, voffA);
            PG8_WAIT_V(8); PG8_WAIT_L(0); PG8_BAR; PG8_MMA(0, 0, At, B0); PG8_MMA(0, 1, At, B1); PG8_BAR; PG8_SCHED;
            PG8_LDA(At, 1, 1); PG8_STAGE(PG8_SB(1, 0), b3, voffB); PG8_STAGE(PG8_SB(1, 1), b3 + hstep, voffB); PG8_STAGE(PG8_SA(1, 0), a3, voffA);
            PG8_WAIT_V(8); PG8_WAIT_L(0); PG8_BAR; PG8_MMA(1, 0, At, B0); PG8_MMA(1, 1, At, B1); PG8_BAR; PG8_SCHED;
            } else {
            PG8_LDB(B0, 0, 0); PG8_SCHED; PG8_LDA(At, 0, 0); PG8_STAGE(PG8_SA(1, 1), a1 + hstep, voffA);
            PG8_WAIT_L(8); PG8_BAR; PG8_WAIT_L(0); PG8_MMA(0, 0, At, B0); PG8_BAR; PG8_SCHED;
            PG8_LDB(B1, 0, 1); PG8_STAGE(PG8_SB(0, 0), b2, voffB);
            PG8_BAR; PG8_WAIT_L(0); PG8_MMA(0, 1, At, B1); PG8_BAR;
            PG8_LDA(At, 0, 1); PG8_STAGE(PG8_SA(0, 0), a2, voffA);
            PG8_BAR; PG8_WAIT_L(0); PG8_MMA(1, 0, At, B0); PG8_BAR; PG8_SCHED;
            PG8_STAGE(PG8_SB(0, 1), b2 + hstep, voffB);
            PG8_WAIT_V(6); PG8_BAR; PG8_MMA(1, 1, At, B1); PG8_BAR;
            PG8_LDB(B0, 1, 0); PG8_SCHED; PG8_LDA(At, 1, 0); PG8_STAGE(PG8_SA(0, 1), a2 + hstep, voffA);
            PG8_WAIT_L(8); PG8_BAR; PG8_WAIT_L(0); PG8_MMA(0, 0, At, B0); PG8_BAR; PG8_SCHED;
            PG8_LDB(B1, 1, 1); PG8_STAGE(PG8_SB(1, 0), b3, voffB);
            PG8_BAR; PG8_WAIT_L(0); PG8_MMA(0, 1, At, B1); PG8_BAR;
            PG8_LDA(At, 1, 1); PG8_STAGE(PG8_SA(1, 0), a3, voffA);
            PG8_BAR; PG8_WAIT_L(0); PG8_MMA(1, 0, At, B0); PG8_BAR; PG8_SCHED;
            PG8_STAGE(PG8_SB(1, 1), b3 + hstep, voffB);
            PG8_WAIT_V(6); PG8_BAR; PG8_MMA(1, 1, At, B1); PG8_BAR;
            }
        }
        if constexpr (ALIGN_EPI) { if (wr == 0) PG8_BAR; }
        if constexpr (!Epi::AFTER_DRAIN) { E(acc, cur, wr, wc, fr, fq); S.done(cur); }
        if (!has_next) break;
#pragma unroll
        for (int a = 0; a < 2; ++a)
#pragma unroll
            for (int b = 0; b < 2; ++b)
#pragma unroll
                for (int m = 0; m < 4; ++m)
#pragma unroll
                    for (int n = 0; n < 2; ++n) acc[a][b][m][n] = (f32x4){0.f, 0.f, 0.f, 0.f};
        cur = nxt; cA = nA; cB = nB; ++ui;
        if constexpr (ALIGN_EPI) { if (wr == 1) PG8_BAR; }
    }
    PG8_WAIT_V(0);
    if constexpr (!ALIGN_EPI) { if (wr == 0) PG8_BAR; }
    PG8_BAR;
    if constexpr (Epi::AFTER_DRAIN) { E.fused(acc, cur, wr, wc, fr, fq, lds, wid, lane); S.done(cur); }
#undef PG8_SA
#undef PG8_SB
#undef PG8_STAGE
#undef PG8_LDA
#undef PG8_LDB
#undef PG8_MMA
#undef PG8_WAIT_V
#undef PG8_WAIT_L
#undef PG8_BAR
#undef PG8_SCHED
}
}

#define LAS __attribute__((address_space(3)))
typedef unsigned short bf16_t;
typedef short bf16x8 __attribute__((ext_vector_type(8)));
typedef short s16x4 __attribute__((ext_vector_type(4)));
typedef float f32x4 __attribute__((ext_vector_type(4)));
typedef float f32x16 __attribute__((ext_vector_type(16)));
typedef unsigned u32x4 __attribute__((ext_vector_type(4)));
typedef unsigned u32x2 __attribute__((ext_vector_type(2)));

constexpr int DM = 1024, SEQ = 8192, NBATCH = 2, CTXL = 256, DEPTH = 4, DFF = 4096, INW = 6144;
constexpr int ML = NBATCH * SEQ, MC = NBATCH * CTXL, MT = ML + MC;
constexpr int NKV = SEQ + CTXL;
constexpr int NTHREADS = 512, NWAVES = 8;
constexpr int LDS_BYTES = 147456;
constexpr float C2 = 0.125f * 1.4426950408889634f;
constexpr float LOG2E = 1.4426950408889634f;

constexpr size_t MiB = 1u << 20;
constexpr size_t WS_ROPE = 0;
constexpr size_t WS_BAR = 16384;
constexpr size_t WS_LAM = 32768;
constexpr size_t WS_MOD = 65536;
constexpr size_t WS_WIN = 1 * MiB;
constexpr size_t WS_WBR = WS_WIN + (size_t)INW * DM * 2;
constexpr size_t WS_WOUT = WS_WBR + (size_t)3 * DM * 512 * 2;
constexpr size_t WS_WF1 = WS_WOUT + (size_t)DM * DM * 2;
constexpr size_t WS_WF2 = WS_WF1 + (size_t)DFF * DM * 2;
constexpr size_t WS_Y = 34 * MiB;
constexpr size_t WS_H = 36 * MiB;
constexpr size_t WS_O = 69 * MiB;
constexpr size_t WS_R = 119 * MiB;
constexpr size_t QSZ = (size_t)MT * 512 * 2;
constexpr size_t R_QA = 0, R_QB = QSZ, R_QC = 2 * QSZ, R_KA = 3 * QSZ;
constexpr size_t KSM = (size_t)NBATCH * NKV * 128 * 2;
constexpr size_t R_KB = R_KA + QSZ, R_KC = R_KB + KSM, R_VTA = R_KC + KSM, R_VTB = R_VTA + QSZ, R_VTC = R_VTB + KSM, R_G = R_VTC + KSM;
constexpr size_t R_T12 = 0, R_U = 0, R_T3 = 132 * MiB;
constexpr size_t WS_TCO = WS_R + 198 * MiB;
constexpr size_t WS_TCF = WS_TCO + 16 * MiB;
constexpr size_t WS_SCR = WS_TCF + 16 * MiB;
constexpr size_t WS_END = WS_SCR;
static_assert(WS_WF2 + (size_t)DM * DFF * 2 <= WS_Y, "weights fit");
static_assert(R_G == 99 * MiB, "overlay map");
static_assert(R_G + (size_t)MT * 3072 * 2 == 198 * MiB, "overlay map G");

struct Args { const float* in[23]; float* out; unsigned char* ws; };
enum { I_X = 0, I_C, I_CTX, I_CCTX, I_WADA, I_BADA, I_GPREMIX, I_GPOSTMIX, I_GPREFF, I_GPOSTFF, I_WIN, I_GQ, I_GK, I_LQ1, I_LK1, I_LQ2, I_LK2, I_GSUB, I_SINK, I_WBR, I_WOUT, I_WF1, I_WF2 };

__device__ __forceinline__ const float* inp(int i) { asm volatile("" : "+s"(i)); return ((const float* const*)__builtin_amdgcn_kernarg_segment_ptr())[i]; }
__device__ __forceinline__ float* outp() { return (float*)inp(23); }
__device__ __forceinline__ unsigned char* wsp() { return (unsigned char*)inp(24); }
typedef float f32x2_t __attribute__((ext_vector_type(2))); typedef __bf16 bf16x2_t __attribute__((ext_vector_type(2)));
__device__ __forceinline__ unsigned cvtpk(float lo, float hi) { const f32x2_t v = {lo, hi}; const bf16x2_t b = __builtin_convertvector(v, bf16x2_t); return __builtin_bit_cast(unsigned, b); }
__device__ __forceinline__ float bf_lo(unsigned u) { return __uint_as_float(u << 16); }
__device__ __forceinline__ float bf_hi(unsigned u) { return __uint_as_float(u & 0xffff0000u); }
__device__ __forceinline__ unsigned short f2bf(float f) { return (unsigned short)(cvtpk(f, f) & 0xffffu); }
__device__ __forceinline__ float wave_sum(float v) {
#pragma unroll
    for (int o = 1; o < 64; o <<= 1) v += __shfl_xor(v, o);
    return v;
}
__device__ __forceinline__ int otid() { int t = threadIdx.x; asm volatile("" : "+v"(t)); return t; }
__device__ __forceinline__ int obx() { int b = blockIdx.x; asm volatile("" : "+s"(b)); return b; }
__device__ __forceinline__ float lam_init_of(int l) { return l == 0 ? 0.2f : (l == 1 ? 0.35550906759096926f : (l == 2 ? 0.47071301834358416f : 0.5560582041556405f)); }

struct EpiG1 {
    static constexpr bool PERM = false, AFTER_DRAIN = false;
    unsigned char* R; const float *rope, *gq, *gk;
    __device__ __forceinline__ void operator()(const f32x4 (&acc)[2][2][4][2], const pg8::Unit& u, int wr, int wc, int fr_, int fq_) const {
        int fr = fr_, fq = fq_; asm volatile("" : "+v"(fr), "+v"(fq));
        bf16_t* const QA = (bf16_t*)(R + R_QA); bf16_t* const QB = (bf16_t*)(R + R_QB); bf16_t* const QC = (bf16_t*)(R + R_QC);
        bf16_t* const KA = (bf16_t*)(R + R_KA); bf16_t* const KB = (bf16_t*)(R + R_KB); bf16_t* const KC = (bf16_t*)(R + R_KC);
        bf16_t* const VTA = (bf16_t*)(R + R_VTA); bf16_t* const VTB = (bf16_t*)(R + R_VTB); bf16_t* const VTC = (bf16_t*)(R + R_VTC); bf16_t* const G = (bf16_t*)(R + R_G);
        const int pm = u.pm, pn = u.pn;
        const bool lat = pm < 64;
        const int b = lat ? (pm >> 5) : (pm - 64);
        const int kvb = lat ? ((pm & 31) << 8) : SEQ;
        const int rl0 = wr * 64 + fr;
        if (pn < 9) {
            const int s = pn * 4 + wc;
            bf16_t* dst; int pitch; bool isK = false; float scale = 1.f; const float* gain = nullptr;
            if (s < 8) { dst = QA + s * 64; pitch = 512; scale = C2; }
            else if (s < 16) { dst = KA + (size_t)b * NKV * 512 + (s - 8) * 64; pitch = 512; isK = true; }
            else if (s < 24) { dst = QB + (s - 16) * 64; pitch = 512; scale = C2; gain = gq; }
            else if (s < 32) { dst = QC + (s - 24) * 64; pitch = 512; scale = C2; }
            else if (s < 34) { dst = KB + (size_t)b * NKV * 128 + (s - 32) * 64; pitch = 128; isK = true; gain = gk; }
            else { dst = KC + (size_t)b * NKV * 128 + (s - 34) * 64; pitch = 128; isK = true; }
            const size_t rbase = isK ? (size_t)kvb : (size_t)pm * 256;
#pragma unroll
            for (int ai = 0; ai < 2; ++ai)
#pragma unroll
                for (int m = 0; m < 4; ++m) {
                    const int rl = ai * 128 + rl0 + m * 16;
                    f32x4 v[2][2];
#pragma unroll
                    for (int bj = 0; bj < 2; ++bj)
#pragma unroll
                        for (int n = 0; n < 2; ++n) v[bj][n] = acc[ai][bj][m][n];
                    if (gain) {
                        float ss = 0.f;
#pragma unroll
                        for (int bj = 0; bj < 2; ++bj)
#pragma unroll
                            for (int n = 0; n < 2; ++n) { const f32x4 x = v[bj][n]; ss += (x[0] * x[0] + x[1] * x[1]) + (x[2] * x[2] + x[3] * x[3]); }
                        ss += __shfl_xor(ss, 16); ss += __shfl_xor(ss, 32);
                        const float rstd = rsqrtf(ss * (1.f / 64.f) + 1e-6f);
#pragma unroll
                        for (int bj = 0; bj < 2; ++bj)
#pragma unroll
                            for (int n = 0; n < 2; ++n) { const f32x4 g4 = *(const f32x4*)(gain + 32 * bj + 16 * n + 4 * fq); v[bj][n] = v[bj][n] * rstd * g4; }
                    }
                    if (lat) {
                        const int t = kvb + rl;
#pragma unroll
                        for (int bj = 0; bj < 2; ++bj) {
                            const int pos = bj ? (t & 63) : (t >> 6);
                            const f32x4 cs = *(const f32x4*)(rope + pos * 32 + 4 * fq), sn = *(const f32x4*)(rope + pos * 32 + 16 + 4 * fq);
                            const f32x4 x1 = v[bj][0], x2 = v[bj][1];
                            v[bj][0] = x1 * cs - x2 * sn; v[bj][1] = x2 * cs + x1 * sn;
                        }
                    }
                    bf16_t* rowp = dst + (rbase + rl) * pitch + 4 * fq;
#pragma unroll
                    for (int bj = 0; bj < 2; ++bj)
#pragma unroll
                        for (int n = 0; n < 2; ++n) { const f32x4 x = v[bj][n] * scale; u32x2 w; w.x = cvtpk(x[0], x[1]); w.y = cvtpk(x[2], x[3]); *(u32x2*)(rowp + 32 * bj + 16 * n) = w; }
                }
        } else if (pn < 12) {
#pragma unroll
            for (int bj = 0; bj < 2; ++bj) {
                bf16_t* vt; int vrow0;
                if (pn < 11) { vt = VTA + (size_t)b * 512 * NKV; vrow0 = (pn - 9) * 256 + 128 * bj + 32 * wc + 4 * fq; }
                else { vt = (bj == 0 ? VTB : VTC) + (size_t)b * 128 * NKV; vrow0 = 32 * wc + 4 * fq; }
#pragma unroll
                for (int n = 0; n < 2; ++n)
#pragma unroll
                    for (int j = 0; j < 4; ++j) {
                        bf16_t* colp = vt + (size_t)(vrow0 + 16 * n + j) * NKV + kvb + rl0;
#pragma unroll
                        for (int ai = 0; ai < 2; ++ai)
#pragma unroll
                            for (int m = 0; m < 4; ++m) colp[ai * 128 + m * 16] = f2bf(acc[ai][bj][m][n][j]);
                    }
            }
        } else {
            const int g0 = (pn - 12) * 256 + 32 * wc + 4 * fq;
#pragma unroll
            for (int ai = 0; ai < 2; ++ai)
#pragma unroll
                for (int m = 0; m < 4; ++m) {
                    bf16_t* rowp = G + ((size_t)pm * 256 + ai * 128 + rl0 + m * 16) * 3072 + g0;
#pragma unroll
                    for (int bj = 0; bj < 2; ++bj)
#pragma unroll
                        for (int n = 0; n < 2; ++n) {
                            const f32x4 x = acc[ai][bj][m][n]; f32x4 y;
#pragma unroll
                            for (int j = 0; j < 4; ++j) y[j] = __builtin_amdgcn_rcpf(1.f + __expf(-x[j]));
                            u32x2 w; w.x = cvtpk(y[0], y[1]); w.y = cvtpk(y[2], y[3]); *(u32x2*)(rowp + 128 * bj + 16 * n) = w;
                        }
                }
        }
    }
};

template <int STEP> struct EpiMerge {
    static constexpr bool PERM = true, AFTER_DRAIN = false;
    const bf16_t* G; bf16_t* T; bf16_t* Z;
    __device__ __forceinline__ void operator()(const f32x4 (&acc)[2][2][4][2], const pg8::Unit& u, int wr, int wc, int fr, int fq) const {
        const int row0 = u.pm * 256 + wr * 64 + fr, col0 = u.pn * 256 + wc * 32 + 8 * fq;
#pragma unroll
        for (int ai = 0; ai < 2; ++ai)
#pragma unroll
            for (int m = 0; m < 4; ++m) {
                const size_t r = (size_t)(row0 + ai * 128 + m * 16);
#pragma unroll
                for (int bj = 0; bj < 2; ++bj) {
                    const int c = col0 + 128 * bj;
                    const u32x4 g = *(const u32x4*)(G + r * 3072 + STEP * 1024 + c);
                    f32x4 v0 = acc[ai][bj][m][0], v1 = acc[ai][bj][m][1];
                    v0 = v0 * (f32x4){bf_lo(g.x), bf_hi(g.x), bf_lo(g.y), bf_hi(g.y)};
                    v1 = v1 * (f32x4){bf_lo(g.z), bf_hi(g.z), bf_lo(g.w), bf_hi(g.w)};
                    bf16_t* tp = (STEP < 2 ? T : Z) + r * 1024 + c;
                    if (STEP > 0) { const u32x4 t = *(const u32x4*)(T + r * 1024 + c);
                        v0 = v0 + (f32x4){bf_lo(t.x), bf_hi(t.x), bf_lo(t.y), bf_hi(t.y)}; v1 = v1 + (f32x4){bf_lo(t.z), bf_hi(t.z), bf_lo(t.w), bf_hi(t.w)}; }
                    u32x4 w; w.x = cvtpk(v0[0], v0[1]); w.y = cvtpk(v0[2], v0[3]); w.z = cvtpk(v1[0], v1[1]); w.w = cvtpk(v1[2], v1[3]); *(u32x4*)tp = w;
                }
            }
    }
};
struct EpiF32 {
    static constexpr bool PERM = false, AFTER_DRAIN = false;
    float* T; int ldc;
    __device__ __forceinline__ void operator()(const f32x4 (&acc)[2][2][4][2], const pg8::Unit& u, int wr, int wc, int fr, int fq) const {
        const int row0 = u.pm * 256 + wr * 64 + fr, col0 = u.pn * 256 + wc * 32 + 4 * fq;
#pragma unroll
        for (int ai = 0; ai < 2; ++ai)
#pragma unroll
            for (int m = 0; m < 4; ++m) {
                float* rowp = T + (size_t)(row0 + ai * 128 + m * 16) * ldc + col0;
#pragma unroll
                for (int bj = 0; bj < 2; ++bj)
#pragma unroll
                    for (int n = 0; n < 2; ++n) *(f32x4*)(rowp + 128 * bj + 16 * n) = acc[ai][bj][m][n];
            }
    }
};
struct CtxSplitOrder {
    pg8::StaticOrder S; int G, c, nl, ksplit, klen, npieces;
    __device__ void init(int N, int K, int G_, int c_, bool with_ctx) { S.init(ML, N, G_, c_); G = G_; c = c_; const int nwg = (ML / 256) * (N / 256); nl = c < nwg ? (nwg - c + G - 1) / G : 0;
        ksplit = 8; klen = K / 8; npieces = with_ctx ? (MC / 256) * (N / 256) * ksplit : 0; }
    __device__ bool next(int i, pg8::Unit& u) const {
        if (i < nl) return S.next(i, u);
        const int q = (i - nl) * G + c; if (q >= npieces) return false;
        const int tile = q / ksplit, kc = q % ksplit; u.pm = ML / 256 + (tile >> 2); u.pn = tile & 3; u.koff = kc * klen; u.nt = klen / 64; return true;
    }
    __device__ __forceinline__ void a_ready(const pg8::Unit&) const {}
    __device__ __forceinline__ void done(const pg8::Unit&) const {}
};
struct EpiF32Split {
    static constexpr bool PERM = false, AFTER_DRAIN = false;
    float* T; float* TC; int klen;
    __device__ __forceinline__ void operator()(const f32x4 (&acc)[2][2][4][2], const pg8::Unit& u, int wr, int wc, int fr, int fq) const {
        const int col0 = u.pn * 256 + wc * 32 + 4 * fq;
        if (u.pm < ML / 256) {
            const int row0 = u.pm * 256 + wr * 64 + fr;
#pragma unroll
            for (int ai = 0; ai < 2; ++ai)
#pragma unroll
                for (int m = 0; m < 4; ++m) {
                    float* rowp = T + (size_t)(row0 + ai * 128 + m * 16) * DM + col0;
#pragma unroll
                    for (int bj = 0; bj < 2; ++bj)
#pragma unroll
                        for (int n = 0; n < 2; ++n) *(f32x4*)(rowp + 128 * bj + 16 * n) = acc[ai][bj][m][n];
                }
        } else {
            const int row0 = (u.pm - ML / 256) * 256 + wr * 64 + fr;
#pragma unroll
            for (int ai = 0; ai < 2; ++ai)
#pragma unroll
                for (int m = 0; m < 4; ++m) {
                    float* rowp = TC + ((size_t)(u.koff / klen) * MC + row0 + ai * 128 + m * 16) * DM + col0;
#pragma unroll
                    for (int bj = 0; bj < 2; ++bj)
#pragma unroll
                        for (int n = 0; n < 2; ++n) *(f32x4*)(rowp + 128 * bj + 16 * n) = acc[ai][bj][m][n];
                }
        }
    }
};
struct EpiSqRelu {
    static constexpr bool PERM = true, AFTER_DRAIN = false;
    bf16_t* U; int ldc;
    __device__ __forceinline__ void operator()(const f32x4 (&acc)[2][2][4][2], const pg8::Unit& u, int wr, int wc, int fr, int fq) const {
        const int row0 = u.pm * 256 + wr * 64 + fr, col0 = u.pn * 256 + wc * 32 + 8 * fq;
#pragma unroll
        for (int ai = 0; ai < 2; ++ai)
#pragma unroll
            for (int m = 0; m < 4; ++m) {
                bf16_t* rowp = U + (size_t)(row0 + ai * 128 + m * 16) * ldc + col0;
#pragma unroll
                for (int bj = 0; bj < 2; ++bj) {
                    f32x4 v0 = acc[ai][bj][m][0], v1 = acc[ai][bj][m][1];
#pragma unroll
                    for (int j = 0; j < 4; ++j) { const float a = fmaxf(v0[j], 0.f), c = fmaxf(v1[j], 0.f); v0[j] = a * a; v1[j] = c * c; }
                    u32x4 w; w.x = cvtpk(v0[0], v0[1]); w.y = cvtpk(v0[2], v0[3]); w.z = cvtpk(v1[0], v1[1]); w.w = cvtpk(v1[2], v1[3]);
                    *(u32x4*)(rowp + 128 * bj) = w;
                }
            }
    }
};

constexpr int KP = 72, VP = 72;
constexpr int KBUFB = 64 * KP * 2, VBUFB = 128 * VP * 2, ABUFB = KBUFB + VBUFB;

template <int DV>
__device__ __forceinline__ void attn_pass(f32x16 (&o)[DV / 32], const bf16_t* qrow, const bf16_t* Kb, int kpitch, const bf16_t* Vtb,
                                          int s0a, int s0b, int s1a, int s1b, bool has_sink, float m_init, float l_init, bool win, int qpos, int qw0, LAS unsigned char* lds) {
    const int tid = otid(), lane = tid & 63, r32 = lane & 31, hi = lane >> 5;
    bf16x8 qf[4];
#pragma unroll
    for (int d0 = 0; d0 < 4; ++d0) qf[d0] = *(const bf16x8*)(qrow + 16 * d0 + 8 * hi);
    asm volatile("" : "+v"(qf[0]), "+v"(qf[1]), "+v"(qf[2]), "+v"(qf[3]));
#pragma unroll
    for (int i = 0; i < DV / 32; ++i)
#pragma unroll
        for (int r = 0; r < 16; ++r) o[i][r] = 0.f;
    float mref = has_sink ? m_init : 0.f, lrun = l_init;
    bool first = !has_sink;
    f32x16 negm;
#pragma unroll
    for (int r = 0; r < 16; ++r) negm[r] = -mref;
    const int n0 = (s0b - s0a) >> 6, nt = n0 + ((s1b - s1a) >> 6);
    const int lrow = tid >> 3, lch = tid & 7;
    const bf16_t* kg = Kb + (size_t)lrow * kpitch + lch * 8;
    const bf16_t* vg = Vtb + (size_t)lrow * NKV + lch * 8;
    const int prow = (lrow & ~12) | ((lrow & 4) << 1) | ((lrow & 8) >> 1);
    const unsigned kst = (unsigned)((prow * KP + lch * 8) * 2), vst = (unsigned)(KBUFB + (lrow * VP + lch * 8) * 2);
    u32x4 kr, vr0, vr1;
    {
        const int k0 = (0 < n0) ? s0a : s1a;
        kr = *(const u32x4*)(kg + (size_t)k0 * kpitch); vr0 = *(const u32x4*)(vg + k0);
        if (DV == 128) vr1 = *(const u32x4*)(vg + (size_t)64 * NKV + k0);
        *(LAS u32x4*)(lds + kst) = kr;
        *(LAS u32x4*)(lds + vst) = vr0;
        if (DV == 128) *(LAS u32x4*)(lds + vst + 64 * VP * 2) = vr1;
    }
    __syncthreads();
    for (int t = 0; t < nt; ++t) {
        const int k0 = (t < n0) ? (s0a + (t << 6)) : (s1a + ((t - n0) << 6));
        const bool more = (t + 1 < nt);
        if (more) {
            const int k1 = (t + 1 < n0) ? (s0a + ((t + 1) << 6)) : (s1a + ((t + 1 - n0) << 6));
            kr = *(const u32x4*)(kg + (size_t)k1 * kpitch); vr0 = *(const u32x4*)(vg + k1);
            if (DV == 128) vr1 = *(const u32x4*)(vg + (size_t)64 * NKV + k1);
        }
        const LAS unsigned char* Kl = lds + (t & 1) * ABUFB;
        const LAS unsigned char* Vl = Kl + KBUFB;
        const bool masked = win && (t < n0);
        const bool skip = masked && ((k0 + 63 < qw0 - 128) || (k0 > qw0 + 31 + 128));
        if (!skip) {
            f32x16 p0, p1;
            {
                bf16x8 kf[8];
#pragma unroll
                for (int d0 = 0; d0 < 4; ++d0) {
                    kf[2 * d0] = *(const LAS bf16x8*)(Kl + (r32 * KP + 16 * d0 + 8 * hi) * 2);
                    kf[2 * d0 + 1] = *(const LAS bf16x8*)(Kl + ((32 + r32) * KP + 16 * d0 + 8 * hi) * 2);
                }
                __builtin_amdgcn_sched_barrier(0);
                p0 = __builtin_amdgcn_mfma_f32_32x32x16_bf16(kf[0], qf[0], negm, 0, 0, 0); p1 = __builtin_amdgcn_mfma_f32_32x32x16_bf16(kf[1], qf[0], negm, 0, 0, 0);
#pragma unroll
                for (int d0 = 1; d0 < 4; ++d0) { p0 = __builtin_amdgcn_mfma_f32_32x32x16_bf16(kf[2 * d0], qf[d0], p0, 0, 0, 0); p1 = __builtin_amdgcn_mfma_f32_32x32x16_bf16(kf[2 * d0 + 1], qf[d0], p1, 0, 0, 0); }
                __builtin_amdgcn_sched_barrier(0);
            }
            bf16x8 vfa[8];
#pragma unroll
            for (int db = 0; db < 2; ++db)
#pragma unroll
                for (int c = 0; c < 4; ++c) vfa[db * 4 + c] = *(const LAS bf16x8*)(Vl + ((32 * db + r32) * VP + 16 * c + 8 * hi) * 2);
            if (masked) {
#pragma unroll
                for (int r = 0; r < 16; ++r) {
                    const int kv = k0 + 16 * (r >> 3) + 8 * hi + 4 * ((r >> 2) & 1) + (r & 3);
                    int d0 = kv - qpos; d0 = d0 < 0 ? -d0 : d0; int d1 = kv + 32 - qpos; d1 = d1 < 0 ? -d1 : d1;
                    if (d0 > 128) p0[r] = -1e30f;
                    if (d1 > 128) p1[r] = -1e30f;
                }
            }
#define MX3(a, b, c) __builtin_fmaxf(__builtin_fmaxf((a), (b)), (c))
            float ma = MX3(p0[0], p0[1], p1[0]), mb = MX3(p0[2], p0[3], p1[1]); ma = MX3(ma, p1[2], p1[3]);
#pragma unroll
            for (int r = 4; r < 16; r += 4) { ma = MX3(ma, p0[r], p0[r + 1]); mb = MX3(mb, p0[r + 2], p0[r + 3]); ma = MX3(ma, p1[r], p1[r + 1]); mb = MX3(mb, p1[r + 2], p1[r + 3]); }
#undef MX3
            float mx = fmaxf(ma, mb);
            mx = fmaxf(mx, __shfl_xor(mx, 32));
            if (first || __any(mx > 8.f)) {
                const float dl = first ? mx : fmaxf(mx, 0.f);
                const float alpha = first ? 1.f : __builtin_amdgcn_exp2f(-dl);
                mref += dl; lrun *= alpha;
#pragma unroll
                for (int r = 0; r < 16; ++r) { p0[r] -= dl; p1[r] -= dl; negm[r] = -mref; }
#pragma unroll
                for (int i = 0; i < DV / 32; ++i)
#pragma unroll
                    for (int r = 0; r < 16; ++r) o[i][r] *= alpha;
                first = false;
            }
            float rs0 = 0.f, rs1 = 0.f;
#pragma unroll
            for (int r = 0; r < 16; ++r) { p0[r] = __builtin_amdgcn_exp2f(p0[r]); p1[r] = __builtin_amdgcn_exp2f(p1[r]); rs0 += p0[r]; rs1 += p1[r]; }
            lrun += rs0 + rs1;
            bf16x8 pk[4];
            { u32x4 w;
              w.x = cvtpk(p0[0], p0[1]); w.y = cvtpk(p0[2], p0[3]); w.z = cvtpk(p0[4], p0[5]); w.w = cvtpk(p0[6], p0[7]); pk[0] = __builtin_bit_cast(bf16x8, w);
              w.x = cvtpk(p0[8], p0[9]); w.y = cvtpk(p0[10], p0[11]); w.z = cvtpk(p0[12], p0[13]); w.w = cvtpk(p0[14], p0[15]); pk[1] = __builtin_bit_cast(bf16x8, w);
              w.x = cvtpk(p1[0], p1[1]); w.y = cvtpk(p1[2], p1[3]); w.z = cvtpk(p1[4], p1[5]); w.w = cvtpk(p1[6], p1[7]); pk[2] = __builtin_bit_cast(bf16x8, w);
              w.x = cvtpk(p1[8], p1[9]); w.y = cvtpk(p1[10], p1[11]); w.z = cvtpk(p1[12], p1[13]); w.w = cvtpk(p1[14], p1[15]); pk[3] = __builtin_bit_cast(bf16x8, w); }
            __builtin_amdgcn_sched_barrier(0);
            if (DV == 128) {
                bf16x8 vfb[8];
#pragma unroll
                for (int db = 2; db < 4; ++db)
#pragma unroll
                    for (int c = 0; c < 4; ++c) vfb[(db - 2) * 4 + c] = *(const LAS bf16x8*)(Vl + ((32 * db + r32) * VP + 16 * c + 8 * hi) * 2);
#pragma unroll
                for (int db = 0; db < 2; ++db)
#pragma unroll
                    for (int c = 0; c < 4; ++c) {
                        o[db] = __builtin_amdgcn_mfma_f32_32x32x16_bf16(vfa[db * 4 + c], pk[c], o[db], 0, 0, 0);
                    }
                __builtin_amdgcn_sched_barrier(0);
#pragma unroll
                for (int db = 2; db < DV / 32; ++db)
#pragma unroll
                    for (int c = 0; c < 4; ++c) {
                        o[db] = __builtin_amdgcn_mfma_f32_32x32x16_bf16(vfb[(db - 2) * 4 + c], pk[c], o[db], 0, 0, 0);
                    }
            } else {
#pragma unroll
                for (int db = 0; db < 2; ++db)
#pragma unroll
                    for (int c = 0; c < 4; ++c) {
                        o[db] = __builtin_amdgcn_mfma_f32_32x32x16_bf16(vfa[db * 4 + c], pk[c], o[db], 0, 0, 0);
                    }
            }
            __builtin_amdgcn_sched_barrier(0);
        }
        if (more) {
            const unsigned bo = ((t + 1) & 1) * ABUFB;
            *(LAS u32x4*)(lds + bo + kst) = kr;
            *(LAS u32x4*)(lds + bo + vst) = vr0;
            if (DV == 128) *(LAS u32x4*)(lds + bo + vst + 64 * VP * 2) = vr1;
        }
        __syncthreads();
    }
    const float lt = lrun + __shfl_xor(lrun, 32);
    const float inv = 1.f / lt;
#pragma unroll
    for (int i = 0; i < DV / 32; ++i)
#pragma unroll
        for (int r = 0; r < 16; ++r) o[i][r] *= inv;
}

__device__ __forceinline__ void attn_pass2(f32x16 (&o)[2][2], const bf16_t* qrow0  , const bf16_t* Kb, const bf16_t* Vtb,
                                           int s0a, int s0b, int s1a, int s1b, bool has_sink, float m_init0, float m_init1, float l_init, bool win, int qpos, int qw0, LAS unsigned char* lds) {
    const int tid = otid(), lane = tid & 63, r32 = lane & 31, hi = lane >> 5;
    constexpr int kpitch = 128;
    bf16x8 qf[2][4];
#pragma unroll
    for (int rb = 0; rb < 2; ++rb)
#pragma unroll
        for (int d0 = 0; d0 < 4; ++d0) qf[rb][d0] = *(const bf16x8*)(qrow0 + 64 * rb + 16 * d0 + 8 * hi);
    asm volatile("" : "+v"(qf[0][0]), "+v"(qf[0][1]), "+v"(qf[0][2]), "+v"(qf[0][3]), "+v"(qf[1][0]), "+v"(qf[1][1]), "+v"(qf[1][2]), "+v"(qf[1][3]));
#pragma unroll
    for (int rb = 0; rb < 2; ++rb)
#pragma unroll
        for (int i = 0; i < 2; ++i)
#pragma unroll
            for (int r = 0; r < 16; ++r) o[rb][i][r] = 0.f;
    float mref[2] = {has_sink ? m_init0 : 0.f, has_sink ? m_init1 : 0.f}, lrun[2] = {l_init, l_init};
    bool first = !has_sink;
    const int n0 = (s0b - s0a) >> 6, nt = n0 + ((s1b - s1a) >> 6);
#define LANE_ADDR() const int tl_ = otid(); const int lrow = tl_ >> 3, lch = tl_ & 7; const bf16_t* kg = Kb + (size_t)lrow * kpitch + lch * 8; const bf16_t* vg = Vtb + (size_t)lrow * NKV + lch * 8; \
        const int prow_ = (lrow & ~12) | ((lrow & 4) << 1) | ((lrow & 8) >> 1); \
        const unsigned kst = (unsigned)((prow_ * KP + lch * 8) * 2), vst = (unsigned)(KBUFB + (lrow * VP + lch * 8) * 2)
#define TILE_K0(t) (((t) < n0) ? (s0a + ((t) << 6)) : (s1a + (((t) - n0) << 6)))
    u32x4 kr, vr0;
    { LANE_ADDR(); const int k0 = TILE_K0(0); kr = *(const u32x4*)(kg + (size_t)k0 * kpitch); vr0 = *(const u32x4*)(vg + k0);
      *(LAS u32x4*)(lds + kst) = kr; *(LAS u32x4*)(lds + vst) = vr0; }
    __syncthreads();
    for (int t = 0; t < nt; ++t) {
        const int k0 = TILE_K0(t);
        const bool more = (t + 1 < nt);
        if (more) { LANE_ADDR(); const int k1 = TILE_K0(t + 1); kr = *(const u32x4*)(kg + (size_t)k1 * kpitch); vr0 = *(const u32x4*)(vg + k1); }
        const LAS unsigned char* Kl = lds + (t & 1) * ABUFB;
        const LAS unsigned char* Vl = Kl + KBUFB;
        const bool masked = win && (t < n0);
        const bool skip = masked && ((k0 + 63 < qw0 - 128) || (k0 > qw0 + 31 + 128));
        if (!skip) {
            f32x16 p[2][2];
            {
                const f32x16 z = {0.f, 0.f, 0.f, 0.f, 0.f, 0.f, 0.f, 0.f, 0.f, 0.f, 0.f, 0.f, 0.f, 0.f, 0.f, 0.f};
#pragma unroll
                for (int g = 0; g < 2; ++g) {
                    bf16x8 kf[4];
#pragma unroll
                    for (int d = 0; d < 2; ++d) {
                        kf[2 * d] = *(const LAS bf16x8*)(Kl + (r32 * KP + 16 * (2 * g + d) + 8 * hi) * 2);
                        kf[2 * d + 1] = *(const LAS bf16x8*)(Kl + ((32 + r32) * KP + 16 * (2 * g + d) + 8 * hi) * 2);
                    }
                    __builtin_amdgcn_sched_barrier(0);
#pragma unroll
                    for (int rb = 0; rb < 2; ++rb)
#pragma unroll
                        for (int d = 0; d < 2; ++d) {
                            if (g == 0 && d == 0) { p[rb][0] = __builtin_amdgcn_mfma_f32_32x32x16_bf16(kf[0], qf[rb][0], z, 0, 0, 0); p[rb][1] = __builtin_amdgcn_mfma_f32_32x32x16_bf16(kf[1], qf[rb][0], z, 0, 0, 0); }
                            else { p[rb][0] = __builtin_amdgcn_mfma_f32_32x32x16_bf16(kf[2 * d], qf[rb][2 * g + d], p[rb][0], 0, 0, 0); p[rb][1] = __builtin_amdgcn_mfma_f32_32x32x16_bf16(kf[2 * d + 1], qf[rb][2 * g + d], p[rb][1], 0, 0, 0); }
                        }
                    __builtin_amdgcn_sched_barrier(0);
                }
            }
            bf16x8 pk[2][4];
            const bool domask = masked && !((k0 >= qw0 + 31 - 128) && (k0 + 63 <= qw0 + 128));
            const int ub = k0 - qpos + 128 + 8 * hi;
#define MX3(a, b, c) __builtin_fmaxf(__builtin_fmaxf((a), (b)), (c))
#pragma unroll
            for (int rb = 0; rb < 2; ++rb) {
                f32x16& p0 = p[rb][0]; f32x16& p1 = p[rb][1];
                if (domask) {
#pragma unroll
                    for (int r = 0; r < 16; ++r) { const unsigned u0 = (unsigned)(ub + 16 * (r >> 3) + 4 * ((r >> 2) & 1) + (r & 3)); if (u0 > 256u) p0[r] = -1e30f; if (u0 + 32u > 256u) p1[r] = -1e30f; }
                }
                float ma = MX3(p0[0], p0[1], p1[0]), mb = MX3(p0[2], p0[3], p1[1]); ma = MX3(ma, p1[2], p1[3]);
#pragma unroll
                for (int r = 4; r < 16; r += 4) { ma = MX3(ma, p0[r], p0[r + 1]); mb = MX3(mb, p0[r + 2], p0[r + 3]); ma = MX3(ma, p1[r], p1[r + 1]); mb = MX3(mb, p1[r + 2], p1[r + 3]); }
                float mx = fmaxf(ma, mb);
                mx = fmaxf(mx, __shfl_xor(mx, 32)) - mref[rb];
                if (first || __any(mx > 8.f)) {
                    const float dl = first ? mx : fmaxf(mx, 0.f);
                    const float alpha = first ? 1.f : __builtin_amdgcn_exp2f(-dl);
                    mref[rb] += dl; lrun[rb] *= alpha;
#pragma unroll
                    for (int i = 0; i < 2; ++i)
#pragma unroll
                        for (int r = 0; r < 16; ++r) o[rb][i][r] *= alpha;
                }
                const float mr = mref[rb];
                float rs0 = 0.f, rs1 = 0.f;
#pragma unroll
                for (int r = 0; r < 16; ++r) { p0[r] = __builtin_amdgcn_exp2f(p0[r] - mr); p1[r] = __builtin_amdgcn_exp2f(p1[r] - mr); rs0 += p0[r]; rs1 += p1[r]; }
                lrun[rb] += rs0 + rs1;
                u32x4 w;
                w.x = cvtpk(p0[0], p0[1]); w.y = cvtpk(p0[2], p0[3]); w.z = cvtpk(p0[4], p0[5]); w.w = cvtpk(p0[6], p0[7]); pk[rb][0] = __builtin_bit_cast(bf16x8, w);
                w.x = cvtpk(p0[8], p0[9]); w.y = cvtpk(p0[10], p0[11]); w.z = cvtpk(p0[12], p0[13]); w.w = cvtpk(p0[14], p0[15]); pk[rb][1] = __builtin_bit_cast(bf16x8, w);
                w.x = cvtpk(p1[0], p1[1]); w.y = cvtpk(p1[2], p1[3]); w.z = cvtpk(p1[4], p1[5]); w.w = cvtpk(p1[6], p1[7]); pk[rb][2] = __builtin_bit_cast(bf16x8, w);
                w.x = cvtpk(p1[8], p1[9]); w.y = cvtpk(p1[10], p1[11]); w.z = cvtpk(p1[12], p1[13]); w.w = cvtpk(p1[14], p1[15]); pk[rb][3] = __builtin_bit_cast(bf16x8, w);
            }
#undef MX3
            first = false;
#pragma unroll
            for (int db = 0; db < 2; ++db) {
                bf16x8 vfr[4];
#pragma unroll
                for (int c = 0; c < 4; ++c) vfr[c] = *(const LAS bf16x8*)(Vl + ((32 * db + r32) * VP + 16 * c + 8 * hi) * 2);
#pragma unroll
                for (int c = 0; c < 4; ++c) {
                    const bf16x8 vf = vfr[c];
                    o[0][db] = __builtin_amdgcn_mfma_f32_32x32x16_bf16(vf, pk[0][c], o[0][db], 0, 0, 0);
                    o[1][db] = __builtin_amdgcn_mfma_f32_32x32x16_bf16(vf, pk[1][c], o[1][db], 0, 0, 0);
                }
            }
        }
        if (more) { LANE_ADDR(); const unsigned bo = ((t + 1) & 1) * ABUFB; *(LAS u32x4*)(lds + bo + kst) = kr; *(LAS u32x4*)(lds + bo + vst) = vr0; }
        __syncthreads();
    }
#undef TILE_K0
#undef LANE_ADDR
#pragma unroll
    for (int rb = 0; rb < 2; ++rb) {
        const float lt = lrun[rb] + __shfl_xor(lrun[rb], 32);
        const float inv = 1.f / lt;
#pragma unroll
        for (int i = 0; i < 2; ++i)
#pragma unroll
            for (int r = 0; r < 16; ++r) o[rb][i][r] *= inv;
    }
}

__device__ __forceinline__ void attn_pass2b(f32x16 (&o)[2][2], const bf16_t* qrow0, const bf16_t* Kb, const bf16_t* Vtb, int ka, int kb, LAS unsigned char* lds) {
    const int tid = otid(), lane = tid & 63, r32 = lane & 31, hi = lane >> 5;
    constexpr int kpitch = 128;
    LAS bf16x8* ql = (LAS bf16x8*)(lds + 2 * ABUFB) + tid;
    {
        bf16x8 qf[8];
#pragma unroll
        for (int i = 0; i < 8; ++i) qf[i] = *(const bf16x8*)(qrow0 + 64 * (i >> 2) + 16 * (i & 3) + 8 * hi);
#pragma unroll
        for (int i = 0; i < 8; ++i) ql[i * 512] = qf[i];
    }
#pragma unroll
    for (int rb = 0; rb < 2; ++rb)
#pragma unroll
        for (int i = 0; i < 2; ++i)
#pragma unroll
            for (int r = 0; r < 16; ++r) o[rb][i][r] = 0.f;
    float mref = 0.f, lrun[2] = {0.f, 0.f};
    f32x16 negm;
#pragma unroll
    for (int r = 0; r < 16; ++r) negm[r] = 0.f;
    bool first = true;
    const int nt = (kb - ka) >> 6;
#define LANE_ADDR() const int tl_ = otid(); const int lrow = tl_ >> 3, lch = tl_ & 7; const bf16_t* kg = Kb + (size_t)(ka + lrow) * kpitch + lch * 8; const bf16_t* vg = Vtb + (size_t)lrow * NKV + ka + lch * 8; \
        const int prow_ = (lrow & ~12) | ((lrow & 4) << 1) | ((lrow & 8) >> 1); \
        const unsigned kst = (unsigned)((prow_ * KP + lch * 8) * 2), vst = (unsigned)(KBUFB + (lrow * VP + lch * 8) * 2)
    u32x4 kr, vr0;
    { LANE_ADDR(); kr = *(const u32x4*)kg; vr0 = *(const u32x4*)vg; *(LAS u32x4*)(lds + kst) = kr; *(LAS u32x4*)(lds + vst) = vr0; }
    __syncthreads();
    for (int t = 0; t < nt; ++t) {
        const bool more = (t + 1 < nt);
        if (more) { LANE_ADDR(); kr = *(const u32x4*)(kg + (size_t)((t + 1) << 6) * kpitch); vr0 = *(const u32x4*)(vg + ((t + 1) << 6)); }
        const LAS unsigned char* Kl = lds + (t & 1) * ABUFB;
        const LAS unsigned char* Vl = Kl + KBUFB;
        f32x16 p[2][2];
#pragma unroll
        for (int g = 0; g < 2; ++g) {
            bf16x8 kf[4], qq[2][2];
#pragma unroll
            for (int d = 0; d < 2; ++d) {
                kf[2 * d] = *(const LAS bf16x8*)(Kl + (r32 * KP + 16 * (2 * g + d) + 8 * hi) * 2);
                kf[2 * d + 1] = *(const LAS bf16x8*)(Kl + ((32 + r32) * KP + 16 * (2 * g + d) + 8 * hi) * 2);
                qq[0][d] = ql[(2 * g + d) * 512]; qq[1][d] = ql[(4 + 2 * g + d) * 512];
            }
            __builtin_amdgcn_sched_barrier(0);
#pragma unroll
            for (int rb = 0; rb < 2; ++rb)
#pragma unroll
                for (int d = 0; d < 2; ++d) {
                    if (g == 0 && d == 0) { p[rb][0] = __builtin_amdgcn_mfma_f32_32x32x16_bf16(kf[0], qq[rb][0], negm, 0, 0, 0); p[rb][1] = __builtin_amdgcn_mfma_f32_32x32x16_bf16(kf[1], qq[rb][0], negm, 0, 0, 0); }
                    else { p[rb][0] = __builtin_amdgcn_mfma_f32_32x32x16_bf16(kf[2 * d], qq[rb][d], p[rb][0], 0, 0, 0); p[rb][1] = __builtin_amdgcn_mfma_f32_32x32x16_bf16(kf[2 * d + 1], qq[rb][d], p[rb][1], 0, 0, 0); }
                }
            __builtin_amdgcn_sched_barrier(0);
        }
#define MX3(a, b, c) __builtin_fmaxf(__builtin_fmaxf((a), (b)), (c))
        float mx;
        {
            float ma = MX3(p[0][0][0], p[0][0][1], p[0][1][0]), mb = MX3(p[1][0][0], p[1][0][1], p[1][1][0]);
#pragma unroll
            for (int rb = 0; rb < 2; ++rb) {
                const f32x16& p0 = p[rb][0]; const f32x16& p1 = p[rb][1];
                ma = MX3(ma, p0[2], p0[3]); mb = MX3(mb, p1[1], p1[2]); ma = MX3(ma, p1[3], p0[4]);
#pragma unroll
                for (int r = 5; r < 16; r += 2) { ma = MX3(ma, p0[r], p0[r + (r < 15 ? 1 : 0)]); mb = MX3(mb, p1[r - 1], p1[r]); }
            }
            mx = fmaxf(ma, mb);
            mx = fmaxf(mx, __shfl_xor(mx, 32));
        }
#undef MX3
        if (first || __any(mx > 8.f)) {
            const float dl = first ? mx : fmaxf(mx, 0.f);
            const float alpha = first ? 1.f : __builtin_amdgcn_exp2f(-dl);
            mref += dl; lrun[0] *= alpha; lrun[1] *= alpha;
#pragma unroll
            for (int r = 0; r < 16; ++r) negm[r] = -mref;
#pragma unroll
            for (int rb = 0; rb < 2; ++rb) {
#pragma unroll
                for (int r = 0; r < 16; ++r) { p[rb][0][r] -= dl; p[rb][1][r] -= dl; }
#pragma unroll
                for (int i = 0; i < 2; ++i)
#pragma unroll
                    for (int r = 0; r < 16; ++r) o[rb][i][r] *= alpha;
            }
            first = false;
        }
        bf16x8 pk[2][4];
#pragma unroll
        for (int rb = 0; rb < 2; ++rb) {
            f32x16& p0 = p[rb][0]; f32x16& p1 = p[rb][1];
            float rs0 = 0.f, rs1 = 0.f;
#pragma unroll
            for (int r = 0; r < 16; ++r) { p0[r] = __builtin_amdgcn_exp2f(p0[r]); p1[r] = __builtin_amdgcn_exp2f(p1[r]); rs0 += p0[r]; rs1 += p1[r]; }
            lrun[rb] += rs0 + rs1;
            u32x4 w;
            w.x = cvtpk(p0[0], p0[1]); w.y = cvtpk(p0[2], p0[3]); w.z = cvtpk(p0[4], p0[5]); w.w = cvtpk(p0[6], p0[7]); pk[rb][0] = __builtin_bit_cast(bf16x8, w);
            w.x = cvtpk(p0[8], p0[9]); w.y = cvtpk(p0[10], p0[11]); w.z = cvtpk(p0[12], p0[13]); w.w = cvtpk(p0[14], p0[15]); pk[rb][1] = __builtin_bit_cast(bf16x8, w);
            w.x = cvtpk(p1[0], p1[1]); w.y = cvtpk(p1[2], p1[3]); w.z = cvtpk(p1[4], p1[5]); w.w = cvtpk(p1[6], p1[7]); pk[rb][2] = __builtin_bit_cast(bf16x8, w);
            w.x = cvtpk(p1[8], p1[9]); w.y = cvtpk(p1[10], p1[11]); w.z = cvtpk(p1[12], p1[13]); w.w = cvtpk(p1[14], p1[15]); pk[rb][3] = __builtin_bit_cast(bf16x8, w);
        }
#pragma unroll
        for (int db = 0; db < 2; ++db) {
            bf16x8 vfr[4];
#pragma unroll
            for (int c = 0; c < 4; ++c) vfr[c] = *(const LAS bf16x8*)(Vl + ((32 * db + r32) * VP + 16 * c + 8 * hi) * 2);
#pragma unroll
            for (int c = 0; c < 4; ++c) {
                o[0][db] = __builtin_amdgcn_mfma_f32_32x32x16_bf16(vfr[c], pk[0][c], o[0][db], 0, 0, 0);
                o[1][db] = __builtin_amdgcn_mfma_f32_32x32x16_bf16(vfr[c], pk[1][c], o[1][db], 0, 0, 0);
            }
        }
        if (more) { LANE_ADDR(); const unsigned bo = ((t + 1) & 1) * ABUFB; *(LAS u32x4*)(lds + bo + kst) = kr; *(LAS u32x4*)(lds + bo + vst) = vr0; }
        __syncthreads();
    }
#undef LANE_ADDR
#pragma unroll
    for (int rb = 0; rb < 2; ++rb) {
        const float lt = lrun[rb] + __shfl_xor(lrun[rb], 32);
        const float inv = 1.f / lt;
#pragma unroll
        for (int i = 0; i < 2; ++i)
#pragma unroll
            for (int r = 0; r < 16; ++r) o[rb][i][r] *= inv;
    }
}

struct AttnPtrs { unsigned char* R; bf16_t* OA; float* scr; const float *gsub, *sink; const float* lamp; int layer; };

__device__ __forceinline__ void attn_phase(const AttnPtrs& P, bool do_ctx, LAS unsigned char* lds) {
    const int NU = 768 + (do_ctx ? 24 : 0);
    for (int u = obx(); u < NU; u += gridDim.x) {
        const int tid = otid(), lane = tid & 63, r32 = lane & 31, hi = lane >> 5;
        const int wid = __builtin_amdgcn_readfirstlane(tid >> 6);
        int kind, b, h, row0, qp0, s0a, s0b, s1a = SEQ, s1b = SEQ; bool win = false, sinkon = false;
        if (u < 256) { kind = 0; const int bh = u & 7, qb = u >> 3; b = bh >> 2; h = bh & 3; qp0 = qb * 256; row0 = b * SEQ + qp0; s0a = 0; s0b = NKV; }
        else if (u < 768) {
            kind = (u < 512) ? 1 : 2; int qb;
            { const int v = (u - 256) & 255; const int x = v & 7; qb = v >> 3; b = x >> 2; h = 2 * (x & 3); }
            qp0 = qb * 256; row0 = b * SEQ + qp0;
            if (kind == 1) { s0a = 0; s0b = NKV; }
            else { s0a = qp0 - 128 < 0 ? 0 : qp0 - 128; s0b = qp0 + 384 > SEQ ? SEQ : qp0 + 384; s1a = SEQ; s1b = NKV; win = true; sinkon = true; }
        } else {
            const int w = u - 768;
            if (w < 8) { kind = 0; b = w >> 2; h = w & 3; }
            else if (w < 16) { kind = 1; b = (w - 8) >> 2; h = 2 * ((w - 8) & 3); }
            else { kind = 2; b = (w - 16) >> 2; h = 2 * ((w - 16) & 3); sinkon = true; }
            qp0 = 0; row0 = ML + b * CTXL; s0a = SEQ; s0b = NKV;
        }
        const int myrow = row0 + wid * 32 + r32;
        const int qw0 = qp0 + wid * 32, qpos = qw0 + r32;
        if (kind == 0) {
            unsigned o1p[4][8];
#pragma unroll 1
            for (int mp = 0; mp < 2; ++mp) {
                f32x16 o[4];
                attn_pass<128>(o, (const bf16_t*)(P.R + R_QA) + (size_t)myrow * 512 + h * 128 + mp * 64, (const bf16_t*)(P.R + R_KA) + (size_t)b * NKV * 512 + h * 128 + mp * 64, 512,
                               (const bf16_t*)(P.R + R_VTA) + ((size_t)b * 512 + h * 128) * NKV, s0a, s0b, s1a, s1b, false, 0.f, 0.f, false, qpos, qw0, lds);
                if (mp == 0) {
#pragma unroll
                    for (int i = 0; i < 4; ++i)
#pragma unroll
                        for (int k = 0; k < 8; ++k) o1p[i][k] = cvtpk(o[i][2 * k], o[i][2 * k + 1]);
                } else {
                    float ss = 0.f;
                    int ly_ = P.layer; asm volatile("" : "+s"(ly_));
                    const float lam_ = P.lamp[ly_];
#pragma unroll
                    for (int i = 0; i < 4; ++i)
#pragma unroll
                        for (int k = 0; k < 8; ++k) {
                            const float d0 = bf_lo(o1p[i][k]) - lam_ * o[i][2 * k], d1 = bf_hi(o1p[i][k]) - lam_ * o[i][2 * k + 1];
                            o[i][2 * k] = d0; o[i][2 * k + 1] = d1; ss += d0 * d0 + d1 * d1;
                        }
                    ss += __shfl_xor(ss, 32);
                    const float sc = rsqrtf(ss * (1.f / 128.f) + 1e-5f) * (1.f - lam_init_of(ly_));
                    bf16_t* op = P.OA + (size_t)myrow * 512 + h * 128 + 4 * hi;
#pragma unroll
                    for (int i = 0; i < 4; ++i)
#pragma unroll
                        for (int g = 0; g < 4; ++g) {
                            const f32x4 gs = *(const f32x4*)(P.gsub + 32 * i + 8 * g + 4 * hi);
                            u32x2 w; w.x = cvtpk(o[i][4 * g] * sc * gs[0], o[i][4 * g + 1] * sc * gs[1]); w.y = cvtpk(o[i][4 * g + 2] * sc * gs[2], o[i][4 * g + 3] * sc * gs[3]);
                            *(u32x2*)(op + 32 * i + 8 * g) = w;
                        }
                }
            }
        } else {
            const bf16_t* Q = (const bf16_t*)(P.R + (kind == 1 ? R_QB : R_QC)); const bf16_t* K = (const bf16_t*)(P.R + (kind == 1 ? R_KB : R_KC)); const bf16_t* VT = (const bf16_t*)(P.R + (kind == 1 ? R_VTB : R_VTC)); bf16_t* O = P.OA + (size_t)MT * 512 * kind;
            const int kvh = h >> 2;
            if (kind == 1) {
                f32x16 o[2][2];
                attn_pass2b(o, Q + (size_t)myrow * 512 + h * 64, K + (size_t)b * NKV * 128 + kvh * 64, VT + ((size_t)b * 128 + kvh * 64) * NKV, s0a, s0b, lds);
                const int tid2 = otid();
                bf16_t* op = O + (size_t)(row0 + (tid2 >> 6) * 32 + (tid2 & 31)) * 512 + h * 64 + 4 * ((tid2 & 63) >> 5);
#pragma unroll
                for (int rb = 0; rb < 2; ++rb)
#pragma unroll
                    for (int i = 0; i < 2; ++i)
#pragma unroll
                        for (int g = 0; g < 4; ++g) { u32x2 w; w.x = cvtpk(o[rb][i][4 * g], o[rb][i][4 * g + 1]); w.y = cvtpk(o[rb][i][4 * g + 2], o[rb][i][4 * g + 3]); *(u32x2*)(op + 64 * rb + 32 * i + 8 * g) = w; }
            } else {
                const float m0 = P.sink[h] * LOG2E, m1 = P.sink[h + 1] * LOG2E, l0 = hi == 0 ? 1.f : 0.f;
                f32x16 o[2][2];
                attn_pass2(o, Q + (size_t)myrow * 512 + h * 64, K + (size_t)b * NKV * 128 + kvh * 64, VT + ((size_t)b * 128 + kvh * 64) * NKV,
                           s0a, s0b, s1a, s1b, true, m0, m1, l0, win, qpos, qw0, lds);
                const int tid2 = otid();
                bf16_t* op = O + (size_t)(row0 + (tid2 >> 6) * 32 + (tid2 & 31)) * 512 + h * 64 + 4 * ((tid2 & 63) >> 5);
#pragma unroll
                for (int rb = 0; rb < 2; ++rb)
#pragma unroll
                    for (int i = 0; i < 2; ++i)
#pragma unroll
                        for (int g = 0; g < 4; ++g) { u32x2 w; w.x = cvtpk(o[rb][i][4 * g], o[rb][i][4 * g + 1]); w.y = cvtpk(o[rb][i][4 * g + 2], o[rb][i][4 * g + 3]); *(u32x2*)(op + 64 * rb + 32 * i + 8 * g) = w; }
            }
        }
    }
}

__device__ __forceinline__ int nat_col_of(int n) {
    if (n < 2304) {
        const int s = 4 * (n >> 8) + ((n & 127) >> 5), d = 32 * ((n & 255) >> 7) + (n & 31);
        int base;
        if (s < 8) base = 64 * s; else if (s < 16) base = 512 + 64 * (s - 8); else if (s < 24) base = 1536 + 64 * (s - 16);
        else if (s < 32) base = 2304 + 64 * (s - 24); else if (s < 34) base = 2048 + 64 * (s - 32); else base = 2816 + 64 * (s - 34);
        return base + d;
    }
    if (n < 2816) return 1024 + (n - 2304);
    if (n < 2944) return 2176 + (n - 2816);
    return n;
}
__device__ __forceinline__ void transpose_item(const float* W, int K, int N, bf16_t* WT, int nat0, int out0, int k0, LAS float* scr, int lane) {
#pragma unroll 8
    for (int i = 0; i < 32; ++i) { const int kk = 2 * i + (lane >> 5); scr[kk * 33 + (lane & 31)] = W[(size_t)(k0 + kk) * N + nat0 + (lane & 31)]; }
    asm volatile("s_waitcnt lgkmcnt(0)" ::: "memory");
    const int c = lane & 7;
#pragma unroll
    for (int j = 0; j < 4; ++j) { const int n = (lane >> 3) + 8 * j; const LAS float* s = scr + (8 * c) * 33 + n;
        u32x4 o; o.x = cvtpk(s[0 * 33], s[1 * 33]); o.y = cvtpk(s[2 * 33], s[3 * 33]); o.z = cvtpk(s[4 * 33], s[5 * 33]); o.w = cvtpk(s[6 * 33], s[7 * 33]);
        *(u32x4*)(WT + (size_t)(out0 + n) * K + k0 + 8 * c) = o; }
    asm volatile("s_waitcnt lgkmcnt(0)" ::: "memory");
}
__device__ __forceinline__ void convert_weights(const Args& a, int l, LAS unsigned char* lds) {
    const int tid = otid(), lane = tid & 63, wave = tid >> 6;
    LAS float* scr = (LAS float*)(lds + wave * 16384);
    const int gw = obx() * NWAVES + wave, NGW = gridDim.x * NWAVES;
    constexpr int I_IN = 16 * 192, I_BR = 8 * 32, I_OUT = 16 * 32, I_F1 = 16 * 128, I_F2 = 64 * 32;
    constexpr int NIT = I_IN + 3 * I_BR + I_OUT + I_F1 + I_F2;
    bf16_t* w_in_t = (bf16_t*)(wsp() + WS_WIN); bf16_t* w_br_t = (bf16_t*)(wsp() + WS_WBR); bf16_t* w_out_t = (bf16_t*)(wsp() + WS_WOUT);
    bf16_t* w_f1_t = (bf16_t*)(wsp() + WS_WF1); bf16_t* w_f2_t = (bf16_t*)(wsp() + WS_WF2);
    for (int it = gw; it < NIT; it += NGW) {
        int r = it;
        if (r < I_IN) { const int kb = r / 192, nb = r % 192; transpose_item(inp(I_WIN) + (size_t)l * DM * INW, DM, INW, w_in_t, nat_col_of(32 * nb), 32 * nb, 64 * kb, scr, lane); continue; } r -= I_IN;
        if (r < 3 * I_BR) { const int i = r / I_BR, q = r % I_BR, kb = q / 32, nb = q % 32;
            transpose_item(inp(I_WBR) + ((size_t)l * 1536 + i * 512) * DM, 512, DM, w_br_t + (size_t)i * DM * 512, 32 * nb, 32 * nb, 64 * kb, scr, lane); continue; } r -= 3 * I_BR;
        if (r < I_OUT) { const int kb = r / 32, nb = r % 32; transpose_item(inp(I_WOUT) + (size_t)l * DM * DM, DM, DM, w_out_t, 32 * nb, 32 * nb, 64 * kb, scr, lane); continue; } r -= I_OUT;
        if (r < I_F1) { const int kb = r / 128, nb = r % 128; transpose_item(inp(I_WF1) + (size_t)l * DM * DFF, DM, DFF, w_f1_t, 32 * nb, 32 * nb, 64 * kb, scr, lane); continue; } r -= I_F1;
        { const int kb = r / 32, nb = r % 32; transpose_item(inp(I_WF2) + (size_t)l * DFF * DM, DFF, DM, w_f2_t, 32 * nb, 32 * nb, 64 * kb, scr, lane); }
    }
}
__device__ __forceinline__ float silu_f(float x) { return x / (1.f + __expf(-x)); }

__device__ __forceinline__ void prologue_small(const Args& a, LAS unsigned char* lds) {
    const int tid = otid();
    if (obx() == 0) {
        float* rope = (float*)(wsp() + WS_ROPE);
        for (int e = tid; e < 128 * 16; e += NTHREADS) {
            const int pos = e >> 4, i = e & 15;
            const float invf = exp2f(-(float)i * (13.287712379549449f / 16.f));
            const float ang = (float)pos * invf;
            const float k = rintf(ang * 0.15915494309189535f);
            float r = fmaf(-k, 6.2831854820251465f, ang); r = fmaf(-k, -1.7484555e-7f, r);
            rope[pos * 32 + i] = __cosf(r); rope[pos * 32 + 16 + i] = __sinf(r);
        }
        if (tid < 256) {
            const int l = tid >> 6, i = tid & 63;
            const float s1 = wave_sum(inp(I_LQ1)[l * 64 + i] * inp(I_LK1)[l * 64 + i]);
            const float s2 = wave_sum(inp(I_LQ2)[l * 64 + i] * inp(I_LK2)[l * 64 + i]);
            if (i == 0) ((float*)(wsp() + WS_LAM))[l] = expf(s1) - expf(s2) + lam_init_of(l);
        }
    }
    LAS float* sv = (LAS float*)lds;
    LAS float* red = (LAS float*)(lds + 12288);
    for (int e = tid; e < 3 * 1024; e += NTHREADS) { const int v = e >> 10, k = e & 1023; sv[e] = silu_f(v < 2 ? inp(I_C)[v * 1024 + k] : inp(I_CCTX)[k]); }
    __syncthreads();
    float* mod = (float*)(wsp() + WS_MOD);
    const int col4 = (tid & 31) * 4, ks = tid >> 5;
    for (int item = obx(); item < 4 * 48; item += gridDim.x) {
        const int l = item / 48, n0 = (item % 48) * 128;
        f32x4 a0 = {0.f, 0.f, 0.f, 0.f}, a1 = a0, a2 = a0;
        const float* wp = inp(I_WADA) + ((size_t)l * 1024 + ks * 64) * INW + n0 + col4;
#pragma unroll 4
        for (int kk = 0; kk < 64; ++kk) {
            const f32x4 w = *(const f32x4*)(wp + (size_t)kk * INW); const int k = ks * 64 + kk;
            a0 = a0 + w * sv[k]; a1 = a1 + w * sv[1024 + k]; a2 = a2 + w * sv[2048 + k];
        }
        *(LAS f32x4*)(red + (ks * 3 + 0) * 128 + col4) = a0; *(LAS f32x4*)(red + (ks * 3 + 1) * 128 + col4) = a1; *(LAS f32x4*)(red + (ks * 3 + 2) * 128 + col4) = a2;
        __syncthreads();
        if (tid < 384) {
            const int v = tid >> 7, cidx = tid & 127; float s = inp(I_BADA)[l * INW + n0 + cidx];
#pragma unroll
            for (int q = 0; q < 16; ++q) s += red[(q * 3 + v) * 128 + cidx];
            mod[((size_t)l * 3 + v) * INW + n0 + cidx] = s;
        }
        __syncthreads();
    }
}

__device__ __forceinline__ void row_phase(const Args& a, const float* T, const float* Tc  , float* zc  , const float* modT  , int gm_off, const float* gpost,
                                          const float* modH  , int sh_off, int sc_off, const float* gpre, bool init, bool wrH, int nrows) {
    const int tid = otid(), lane = tid & 63, wave = tid >> 6;
    const int gw = obx() * NWAVES + wave, NGW = gridDim.x * NWAVES;
    float* Y = (float*)(wsp() + WS_Y); bf16_t* H = (bf16_t*)(wsp() + WS_H);
    for (int r = gw; r < nrows; r += NGW) {
        const int mi = r < SEQ ? 0 : (r < ML ? 1 : 2);
        float* xrow = r < ML ? outp() + (size_t)r * DM : Y + (size_t)(r - ML) * DM;
        const float* src = init ? (r < ML ? inp(I_X) + (size_t)r * DM : inp(I_CTX) + (size_t)(r - ML) * DM) : xrow;
        f32x4 x[4];
#pragma unroll
        for (int j = 0; j < 4; ++j) x[j] = *(const f32x4*)(src + 256 * j + 4 * lane);
        if (T) {
            f32x4 t[4]; float ss = 0.f;
            const float* trow = r < ML ? T + (size_t)r * DM : Tc + (size_t)(r - ML) * DM;
#pragma unroll
            for (int j = 0; j < 4; ++j) { t[j] = *(const f32x4*)(trow + 256 * j + 4 * lane);
                if (r >= ML) {
#pragma unroll
                    for (int s = 1; s < 8; ++s) t[j] = t[j] + *(const f32x4*)(trow + (size_t)s * MC * DM + 256 * j + 4 * lane);
                } ss += (t[j][0] * t[j][0] + t[j][1] * t[j][1]) + (t[j][2] * t[j][2] + t[j][3] * t[j][3]); }
            const float rstd = rsqrtf(wave_sum(ss) * (1.f / DM) + 1e-6f);
            const float* gm = modT + (size_t)mi * INW + gm_off;
#pragma unroll
            for (int j = 0; j < 4; ++j) { const int c = 256 * j + 4 * lane; const f32x4 g = *(const f32x4*)(gm + c), gp = *(const f32x4*)(gpost + c); x[j] = x[j] + g * (t[j] * rstd * gp); }
        }
        if (T || init) {
#pragma unroll
            for (int j = 0; j < 4; ++j) *(f32x4*)(xrow + 256 * j + 4 * lane) = x[j];
        }
        if (wrH) {
            float ss = 0.f;
#pragma unroll
            for (int j = 0; j < 4; ++j) ss += (x[j][0] * x[j][0] + x[j][1] * x[j][1]) + (x[j][2] * x[j][2] + x[j][3] * x[j][3]);
            const float rstd = rsqrtf(wave_sum(ss) * (1.f / DM) + 1e-6f);
            const float* sh = modH + (size_t)mi * INW + sh_off; const float* sc = modH + (size_t)mi * INW + sc_off;
#pragma unroll
            for (int j = 0; j < 4; ++j) { const int c = 256 * j + 4 * lane; const f32x4 gp = *(const f32x4*)(gpre + c), s1 = *(const f32x4*)(sc + c), s0 = *(const f32x4*)(sh + c);
                const f32x4 hv = (x[j] * rstd * gp) * (1.f + s1) + s0; u32x2 w; w.x = cvtpk(hv[0], hv[1]); w.y = cvtpk(hv[2], hv[3]); *(u32x2*)(H + (size_t)r * DM + c) = w; }
        }
    }
}

#define XB_TMO      128
#define XB_XCNT(j)  (256  + 64 * (j))
#define XB_XSUB(j)  (1280 + 64 * (j))
#define XB_XGEN(j)  (2304 + 64 * (j))
#define XB_TOP      3328
#define XB_TOPGEN   3392
#define XCD_BAR_WORDS 3456
#define XB_SPIN_CAP (1u << 20)

__device__ __forceinline__ unsigned xb_ld(unsigned* p)              { return __hip_atomic_load(p, __ATOMIC_RELAXED, __HIP_MEMORY_SCOPE_AGENT); }
__device__ __forceinline__ unsigned xb_add(unsigned* p, unsigned v) { return __hip_atomic_fetch_add(p, v, __ATOMIC_RELAXED, __HIP_MEMORY_SCOPE_AGENT); }
__device__ __forceinline__ unsigned xb_xcc_id() { return (unsigned)__builtin_amdgcn_s_getreg((3 << 11) | 20) & 0xFu; }
#define XB_SPIN(cond, bar) do { unsigned _sp = 0; while (cond) { __builtin_amdgcn_s_sleep(1); \
    if ((++_sp & 255u) == 0u) { if (xb_ld(&(bar)[XB_TMO])) break; if (_sp > XB_SPIN_CAP) { atomicAdd(&(bar)[XB_TMO], 1u); break; } } } } while (0)

struct XcdBarrier {
    unsigned* bar; unsigned x;
    volatile LAS unsigned* st;
};

__device__ __forceinline__ XcdBarrier xcd_barrier_post(unsigned* bar, volatile LAS unsigned* st) {
    XcdBarrier b; b.bar = bar; b.x = xb_xcc_id(); b.st = st;
    if (threadIdx.x == 0) (void)xb_add(&bar[XB_XCNT(b.x)], 1u);
    return b;
}
__device__ __forceinline__ void xcd_barrier_complete(unsigned* bar, unsigned x, unsigned& nloc, unsigned& nx) {
    const unsigned G = gridDim.x * gridDim.y * gridDim.z;
    unsigned sum, cnt, mine, sp = 0u;
    for (;;) {
        sum = 0u; cnt = 0u; mine = 0u;
#pragma unroll
        for (unsigned j = 0; j < 16; ++j) { const unsigned c = xb_ld(&bar[XB_XCNT(j)]); sum += c; cnt += (c > 0u) ? 1u : 0u; mine = (j == x) ? c : mine; }
        if (sum == G) break;
        __builtin_amdgcn_s_sleep(1);
        if ((++sp & 255u) == 0u) { if (xb_ld(&bar[XB_TMO])) break; if (sp > XB_SPIN_CAP) { atomicAdd(&bar[XB_TMO], 1u); break; } }
    }
    nloc = mine > 0u ? mine : 1u; nx = cnt > 0u ? cnt : 1u;
}

__device__ __forceinline__ void xcd_barrier(const XcdBarrier& b) {
    asm volatile("s_waitcnt vmcnt(0)" ::: "memory");
    __syncthreads();
    if (threadIdx.x == 0) {
        unsigned* bar = b.bar;
        __builtin_amdgcn_s_waitcnt(0);
        unsigned nloc = b.st[0], nx = b.st[1];
        if (nloc == 0u) { xcd_barrier_complete(bar, b.x, nloc, nx); b.st[0] = nloc; b.st[1] = nx; }
        const unsigned old = xb_add(&bar[XB_XSUB(b.x)], 1u);
        const unsigned gen = old / nloc;
        if (old + 1u == (gen + 1u) * nloc) {
            __builtin_amdgcn_fence(__ATOMIC_RELEASE, "agent");
            asm volatile("s_waitcnt vmcnt(0)" ::: "memory");
            const unsigned og = xb_add(&bar[XB_TOP], 1u);
            const unsigned tg = og / nx;
            if (og + 1u == (tg + 1u) * nx) xb_add(&bar[XB_TOPGEN], 1u);
            else XB_SPIN(xb_ld(&bar[XB_TOPGEN]) == tg, bar);
            __builtin_amdgcn_fence(__ATOMIC_ACQUIRE, "agent");
            xb_add(&bar[XB_XGEN(b.x)], 1u);
            asm volatile("s_waitcnt vmcnt(0)" ::: "memory");
        } else {
            XB_SPIN(xb_ld(&bar[XB_XGEN(b.x)]) == gen, bar);
            __builtin_amdgcn_fence(__ATOMIC_ACQUIRE, "agent");
            asm volatile("s_waitcnt vmcnt(0)" ::: "memory");
        }
    }
    __syncthreads();
}

__global__ void __launch_bounds__(NTHREADS) mega_fwd(Args a) {
    extern __shared__ __attribute__((aligned(16))) unsigned char lds_raw[];
    LAS unsigned char* lds = (LAS unsigned char*)lds_raw;
    cg::grid_group grid = cg::this_grid();
    volatile LAS unsigned* xst = (volatile LAS unsigned*)(lds + 131328);
    if (otid() == 0) { xst[0] = 0u; xst[1] = 0u; }
    __syncthreads();
    (void)xcd_barrier_post((unsigned*)(wsp() + WS_BAR), xst);
#define GSYNC() do { XcdBarrier b_; b_.bar = (unsigned*)(wsp() + WS_BAR); b_.x = xb_xcc_id(); b_.st = xst; xcd_barrier(b_); } while (0)
#define WSP(T, off) ((T*)(wsp() + (off)))
#define MODL(l) (WSP(const float, WS_MOD) + (size_t)(l) * 3 * INW)
    prologue_small(a, lds);
    convert_weights(a, 0, lds);
    grid.sync();
    row_phase(a, nullptr, nullptr, WSP(float, WS_TCO), MODL(0), 0, nullptr, MODL(0), 0, 1024, inp(I_GPREMIX), true, true, MT);
    GSYNC();

#pragma unroll 1
    for (int l = 0; l < DEPTH; ++l) {
        const int MR = (l < DEPTH - 1) ? MT : ML;
#ifndef NO_G1
        { pg8::Gemm g{WSP(bf16_t, WS_H), WSP(bf16_t, WS_WIN), MT, INW, DM}; pg8::StaticOrder S; S.init(MT, INW, (int)gridDim.x, obx());
          EpiG1 E{wsp() + WS_R, WSP(const float, WS_ROPE), inp(I_GQ) + l * 64, inp(I_GK) + l * 64};
          pg8::gemm_phase<EpiG1, pg8::StaticOrder, true, true>(lds, g, S, E); }
#endif
        GSYNC();
#ifndef NO_ATT
        { AttnPtrs P{wsp() + WS_R, WSP(bf16_t, WS_O), WSP(float, WS_SCR), inp(I_GSUB) + l * 128, inp(I_SINK) + l * 8, WSP(const float, WS_LAM), l};
          attn_phase(P, l < DEPTH - 1, lds); }
#endif
        GSYNC();
#ifndef NO_MRG
        { pg8::StaticOrder S; S.init(MR, DM, (int)gridDim.x, obx());
          { pg8::Gemm g{WSP(bf16_t, WS_O), WSP(bf16_t, WS_WBR), MR, DM, 512}; EpiMerge<0> E{WSP(bf16_t, WS_R + R_G), WSP(bf16_t, WS_R + R_T12), WSP(bf16_t, WS_H)};
            pg8::gemm_phase<EpiMerge<0>, pg8::StaticOrder, true, true>(lds, g, S, E); }
          { pg8::Gemm g{WSP(bf16_t, WS_O) + (size_t)MT * 512, WSP(bf16_t, WS_WBR) + (size_t)DM * 512, MR, DM, 512}; EpiMerge<1> E{WSP(bf16_t, WS_R + R_G), WSP(bf16_t, WS_R + R_T12), WSP(bf16_t, WS_H)};
            pg8::gemm_phase<EpiMerge<1>, pg8::StaticOrder, true, true>(lds, g, S, E); }
          { pg8::Gemm g{WSP(bf16_t, WS_O) + (size_t)2 * MT * 512, WSP(bf16_t, WS_WBR) + (size_t)2 * DM * 512, MR, DM, 512}; EpiMerge<2> E{WSP(bf16_t, WS_R + R_G), WSP(bf16_t, WS_R + R_T12), WSP(bf16_t, WS_H)};
            pg8::gemm_phase<EpiMerge<2>, pg8::StaticOrder, true, true>(lds, g, S, E); } }
#endif
        GSYNC();
#ifndef NO_OUT
        { pg8::Gemm g{WSP(bf16_t, WS_H), WSP(bf16_t, WS_WOUT), MR, DM, DM}; CtxSplitOrder S; S.init(DM, DM, (int)gridDim.x, obx(), l < DEPTH - 1); EpiF32Split E{WSP(float, WS_R + R_T12), WSP(float, WS_TCO), DM / 8};
          pg8::gemm_phase<EpiF32Split, CtxSplitOrder, true, true>(lds, g, S, E); }
#endif
        GSYNC();
        row_phase(a, WSP(const float, WS_R + R_T12), WSP(const float, WS_TCO), WSP(float, WS_TCF), MODL(l), 2048, inp(I_GPOSTMIX) + l * DM, MODL(l), 3072, 4096, inp(I_GPREFF) + l * DM, false, true, MR);
        GSYNC();
#ifndef NO_FFN
        { pg8::Gemm g{WSP(bf16_t, WS_H), WSP(bf16_t, WS_WF1), MR, DFF, DM}; pg8::StaticOrder S; S.init(MR, DFF, (int)gridDim.x, obx()); EpiSqRelu E{WSP(bf16_t, WS_R + R_U), DFF};
          pg8::gemm_phase<EpiSqRelu, pg8::StaticOrder, true, true>(lds, g, S, E); }
        GSYNC();
        { pg8::Gemm g{WSP(bf16_t, WS_R + R_U), WSP(bf16_t, WS_WF2), MR, DM, DFF}; CtxSplitOrder S; S.init(DM, DFF, (int)gridDim.x, obx(), l < DEPTH - 1); EpiF32Split E{WSP(float, WS_R + R_T3), WSP(float, WS_TCF), DFF / 8};
          pg8::gemm_phase<EpiF32Split, CtxSplitOrder, true, true>(lds, g, S, E); }
#endif
        GSYNC();
        if (l < DEPTH - 1) {
            row_phase(a, WSP(const float, WS_R + R_T3), WSP(const float, WS_TCF), WSP(float, WS_TCO), MODL(l), 5120, inp(I_GPOSTFF) + l * DM, MODL(l + 1), 0, 1024, inp(I_GPREMIX) + (l + 1) * DM, false, true, MT);
            convert_weights(a, l + 1, lds);
            GSYNC();
        } else {
            row_phase(a, WSP(const float, WS_R + R_T3), WSP(const float, WS_TCF), nullptr, MODL(l), 5120, inp(I_GPOSTFF) + l * DM, MODL(l), 0, 1024, inp(I_GPREMIX), false, false, ML);
        }
    }
}

extern "C" void kernel_launch(void* const* d_in, const int* in_sizes, int n_in, void* d_out, int out_size, void* d_ws, size_t ws_size, hipStream_t stream) {
    static int grid = 0;
    if (grid == 0) {
        if (n_in != 23 || ws_size < WS_END) { fprintf(stderr, "kernel_launch: unexpected n_in %d / ws %zu (need %zu)\n", n_in, ws_size, (size_t)WS_END); grid = -1; return; }
        int dev = 0, cus = 0, per_cu = 0;
        hipGetDevice(&dev);
        hipDeviceGetAttribute(&cus, hipDeviceAttributeMultiprocessorCount, dev);
        if (hipFuncSetAttribute((const void*)mega_fwd, hipFuncAttributeMaxDynamicSharedMemorySize, LDS_BYTES) != hipSuccess) { fprintf(stderr, "kernel_launch: hipFuncSetAttribute failed\n"); }
        if (hipOccupancyMaxActiveBlocksPerMultiprocessor(&per_cu, (const void*)mega_fwd, NTHREADS, LDS_BYTES) != hipSuccess || per_cu < 1) per_cu = 1;
        (void)hipGetLastError();
        grid = cus * per_cu;
    }
    if (grid < 0) return;
    Args a{};
    for (int i = 0; i < 23; ++i) a.in[i] = (const float*)d_in[i];
    a.out = (float*)d_out; a.ws = (unsigned char*)d_ws;
    (void)hipMemsetAsync((char*)d_ws + WS_BAR, 0, 16384, stream);
    void* args[] = {&a};
    hipError_t e = hipLaunchCooperativeKernel((const void*)mega_fwd, dim3(grid), dim3(NTHREADS), args, LDS_BYTES, stream);
    if (e != hipSuccess) fprintf(stderr, "cooperative launch failed: %s (grid %d)\n", hipGetErrorString(e), grid);
}
```

```cpp
#include <hip/hip_runtime.h>
#include <hip/hip_cooperative_groups.h>
#include <cstdio>
#include <cstdint>
namespace cg = cooperative_groups;
namespace pg8 {
#define PG8_LAS __attribute__((address_space(3)))
typedef unsigned short bf16_t;
typedef short bf16x8 __attribute__((ext_vector_type(8)));
typedef float f32x4 __attribute__((ext_vector_type(4)));
typedef unsigned u32x4 __attribute__((ext_vector_type(4)));
constexpr int BM = 256, BK = 64, HALF = 128, HTB = HALF * BK * 2  , STAGE_BYTES = 8 * HTB, NXCD = 8, WGM = 8;

__host__ __device__ __forceinline__ int lds_byte(int r, int c) { const int st = (r >> 4) * 2 + (c >> 5), rr = r & 15, cc = c & 31, ob = rr * 64 + cc * 2; return st * 1024 + (ob ^ (((ob >> 9) & 1) << 5)); }
__host__ __device__ __forceinline__ void stage_rc(int b, int& R, int& C) { const int st = b / 1024, sb = b % 1024, swz = sb ^ (((sb >> 9) & 1) << 5); R = (st >> 1) * 16 + swz / 64; C = (st & 1) * 32 + (swz % 64) / 2; }
__host__ __device__ __forceinline__ int perm32(int rho) { const int n = rho >> 4, i = rho & 15; return 8 * (i >> 2) + 4 * n + (i & 3); }

struct Unit { int pm, pn, koff, nt; };
struct Gemm { const bf16_t* A; const bf16_t* Bt; int M, N, K; };

struct StaticOrder {
    int nM, nN, nwg, G, c;
    __host__ __device__ void init(int M, int N, int G_, int c_) { nM = M / BM; nN = N / BM; nwg = nM * nN; G = G_; c = c_; }
    __host__ __device__ bool next(int i, Unit& u) const {
        const long L = (long)i * G + c; if (L >= nwg) return false;
        int wgid = (int)L; { const int q = nwg / NXCD, r = nwg % NXCD, xcd = wgid % NXCD, off = wgid / NXCD; wgid = (xcd < r ? xcd * (q + 1) : r * (q + 1) + (xcd - r) * q) + off; }
        const int nig = WGM * nN, gid = wgid / nig, fm = gid * WGM, gsz = (nM - fm) < WGM ? (nM - fm) : WGM;
        u.pm = fm + ((wgid % nig) % gsz); u.pn = (wgid % nig) / gsz; u.koff = 0; u.nt = 0; return true;
    }
    __device__ __forceinline__ void a_ready(const Unit&) const {}
    __device__ __forceinline__ void done(const Unit&) const {}
};

template <class Epi, class Sched, bool ALIGN_EPI = false, bool SP2 = false>
__device__ __forceinline__ void gemm_phase(PG8_LAS unsigned char* lds, const Gemm g, const Sched& S, const Epi& E) {
    int tid_ = threadIdx.x; asm volatile("" : "+v"(tid_)); const int tid = tid_, wid = __builtin_amdgcn_readfirstlane(tid >> 6), lane = tid & 63, wr = wid >> 2, wc = wid & 3, fr = lane & 15, fq = lane >> 4;
    const int K = g.K, nt_full = K / BK;
    unsigned voffA[2], voffB[2];
#pragma unroll
    for (int i = 0; i < 2; ++i) { int R, C; stage_rc(tid * 16 + i * 8192, R, C); const int Rb = Epi::PERM ? ((R & ~31) + perm32(R & 31)) : R;
        voffA[i] = (unsigned)(R * K + C) * 2u; voffB[i] = (unsigned)(Rb * K + C) * 2u; }
    const size_t kstep = (size_t)(BK * 2);
    const size_t hstep = (size_t)HALF * K * 2;
    const size_t tstep = 2 * hstep;
    const unsigned ldsw = (unsigned)wid * 1024u;
    const int aoff = lds_byte(wr * 64 + fr, fq * 8), boff = lds_byte(wc * 32 + fr, fq * 8);
#define PG8_SA(b, h) (((b) * 2 + (h)) * HTB)
#define PG8_SB(b, h) ((4 + (b) * 2 + (h)) * HTB)
#define PG8_STAGE(bufoff, gbase, voff) do { _Pragma("unroll") for (int _i = 0; _i < 2; ++_i) \
        __builtin_amdgcn_global_load_lds((const unsigned*)((const char*)(gbase) + (voff)[_i]), (PG8_LAS unsigned*)(lds + (bufoff) + ldsw + _i * 8192), 16, 0, 0); } while (0)
#define PG8_LDA(dst, b, h) do { _Pragma("unroll") for (int m = 0; m < 4; ++m) _Pragma("unroll") for (int k = 0; k < 2; ++k) dst[m][k] = *(const PG8_LAS bf16x8*)(lds + PG8_SA(b, h) + aoff + m * 2048 + k * 1024); } while (0)
#define PG8_LDB(dst, b, h) do { _Pragma("unroll") for (int n = 0; n < 2; ++n) _Pragma("unroll") for (int k = 0; k < 2; ++k) dst[n][k] = *(const PG8_LAS bf16x8*)(lds + PG8_SB(b, h) + boff + n * 2048 + k * 1024); } while (0)
#define PG8_MMA(ai, bj, At, Bt) do { __builtin_amdgcn_s_setprio(1); _Pragma("unroll") for (int m = 0; m < 4; ++m) _Pragma("unroll") for (int n = 0; n < 2; ++n) _Pragma("unroll") for (int k = 0; k < 2; ++k) \
        acc[ai][bj][m][n] = __builtin_amdgcn_mfma_f32_16x16x32_bf16(Bt[n][k], At[m][k], acc[ai][bj][m][n], 0, 0, 0); __builtin_amdgcn_s_setprio(0); } while (0)
#define PG8_WAIT_V(n) asm volatile("s_waitcnt vmcnt(" #n ")" ::: "memory")
#define PG8_WAIT_L(n) asm volatile("s_waitcnt lgkmcnt(" #n ")" ::: "memory")
#define PG8_BAR __builtin_amdgcn_s_barrier()
#define PG8_SCHED __builtin_amdgcn_sched_barrier(0)
    Unit cur, nxt; int ui = 0;
    if (!S.next(0, cur)) return;
    f32x4 acc[2][2][4][2];
#pragma unroll
    for (int a = 0; a < 2; ++a)
#pragma unroll
        for (int b = 0; b < 2; ++b)
#pragma unroll
            for (int m = 0; m < 4; ++m)
#pragma unroll
                for (int n = 0; n < 2; ++n) acc[a][b][m][n] = (f32x4){0.f, 0.f, 0.f, 0.f};
    bf16x8 At[4][2], B0[2][2], B1[2][2];
    const char* cA = (const char*)g.A + (size_t)cur.pm * tstep + (size_t)cur.koff * 2; const char* cB = (const char*)g.Bt + (size_t)cur.pn * tstep + (size_t)cur.koff * 2;
    S.a_ready(cur);
    if constexpr (SP2) {
        PG8_STAGE(PG8_SB(0, 0), cB, voffB); PG8_STAGE(PG8_SB(0, 1), cB + hstep, voffB); PG8_STAGE(PG8_SA(0, 0), cA, voffA); PG8_STAGE(PG8_SA(0, 1), cA + hstep, voffA);
        if (wr == 1) PG8_BAR;
        PG8_WAIT_V(2); PG8_BAR;
        PG8_STAGE(PG8_SB(1, 0), cB + kstep, voffB); PG8_STAGE(PG8_SA(1, 0), cA + kstep, voffA); PG8_STAGE(PG8_SB(1, 1), cB + hstep + kstep, voffB);
        PG8_WAIT_V(6); PG8_BAR;
    } else {
        PG8_STAGE(PG8_SB(0, 0), cB, voffB); PG8_STAGE(PG8_SA(0, 0), cA, voffA); PG8_STAGE(PG8_SB(0, 1), cB + hstep, voffB); PG8_STAGE(PG8_SA(0, 1), cA + hstep, voffA);
        if (wr == 1) PG8_BAR;
        PG8_WAIT_V(4); PG8_BAR;
        PG8_STAGE(PG8_SB(1, 0), cB + kstep, voffB); PG8_STAGE(PG8_SA(1, 0), cA + kstep, voffA); PG8_STAGE(PG8_SB(1, 1), cB + hstep + kstep, voffB);
        PG8_WAIT_V(6); PG8_BAR;
    }
    for (;;) {
        const bool has_next = S.next(ui + 1, nxt);
        const char* nA = has_next ? (const char*)g.A + (size_t)nxt.pm * tstep + (size_t)nxt.koff * 2 : cA; const char* nB = has_next ? (const char*)g.Bt + (size_t)nxt.pn * tstep + (size_t)nxt.koff * 2 : cB;
        const int nt = cur.nt ? cur.nt : nt_full;
        for (int t = 0; t < nt; t += 2) {
            const bool last = (t == nt - 2);
            const char* a1 = cA + (size_t)(t + 1) * kstep;
            const char* a2 = last ? nA : cA + (size_t)(t + 2) * kstep; const char* b2 = last ? nB : cB + (size_t)(t + 2) * kstep;
            const char* a3 = a2 + kstep; const char* b3 = b2 + kstep;
            if (last && has_next) S.a_ready(nxt);
            if constexpr (SP2) {
            PG8_LDB(B0, 0, 0); PG8_LDB(B1, 0, 1); PG8_SCHED; PG8_LDA(At, 0, 0); PG8_STAGE(PG8_SA(1, 1), a1 + hstep, voffA);
            PG8_WAIT_V(8); PG8_WAIT_L(0); PG8_BAR; PG8_MMA(0, 0, At, B0); PG8_MMA(0, 1, At, B1); PG8_BAR; PG8_SCHED;
            PG8_LDA(At, 0, 1); PG8_STAGE(PG8_SB(0, 0), b2, voffB); PG8_STAGE(PG8_SB(0, 1), b2 + hstep, voffB); PG8_STAGE(PG8_SA(0, 0), a2, voffA);
            PG8_WAIT_V(8); PG8_WAIT_L(0); PG8_BAR; PG8_MMA(1, 0, At, B0); PG8_MMA(1, 1, At, B1); PG8_BAR; PG8_SCHED;
            PG8_LDB(B0, 1, 0); PG8_LDB(B1, 1, 1); PG8_SCHED; PG8_LDA(At, 1, 0); PG8_STAGE(PG8_SA(0, 1), a2 + hstep, voffA);
            PG8_WAIT_V(8); PG8_WAIT_L(0); PG8_BAR; PG8_MMA(0, 0, At, B0); PG8_MMA(0, 1, At, B1); PG8_BAR; PG8_SCHED;
            PG8_LDA(At, 1, 1); PG8_STAGE(PG8_SB(1, 0), b3, voffB); PG8_STAGE(PG8_SB(1, 1), b3 + hstep, voffB); PG8_STAGE(PG8_SA(1, 0), a3, voffA);
            PG8_WAIT_V(8); PG8_WAIT_L(0); PG8_BAR; PG8_MMA(1, 0, At, B0); PG8_MMA(1, 1, At, B1); PG8_BAR; PG8_SCHED;
            } else {
            PG8_LDB(B0, 0, 0); PG8_SCHED; PG8_LDA(At, 0, 0); PG8_STAGE(PG8_SA(1, 1), a1 + hstep, voffA);
            PG8_WAIT_L(8); PG8_BAR; PG8_WAIT_L(0); PG8_MMA(0, 0, At, B0); PG8_BAR; PG8_SCHED;
            PG8_LDB(B1, 0, 1); PG8_STAGE(PG8_SB(0, 0), b2, voffB);
            PG8_BAR; PG8_WAIT_L(0); PG8_MMA(0, 1, At, B1); PG8_BAR;
            PG8_LDA(At, 0, 1); PG8_STAGE(PG8_SA(0, 0), a2, voffA);
            PG8_BAR; PG8_WAIT_L(0); PG8_MMA(1, 0, At, B0); PG8_BAR; PG8_SCHED;
            PG8_STAGE(PG8_SB(0, 1), b2 + hstep, voffB);
            PG8_WAIT_V(6); PG8_BAR; PG8_MMA(1, 1, At, B1); PG8_BAR;
            PG8_LDB(B0, 1, 0); PG8_SCHED; PG8_LDA(At, 1, 0); PG8_STAGE(PG8_SA(0, 1), a2 + hstep, voffA);
            PG8_WAIT_L(8); PG8_BAR; PG8_WAIT_L(0); PG8_MMA(0, 0, At, B0); PG8_BAR; PG8_SCHED;
            PG8_LDB(B1, 1, 1); PG8_STAGE(PG8_SB(1, 0), b3, voffB);
            PG8_BAR; PG8_WAIT_L(0); PG8_MMA(0, 1, At, B1); PG8_BAR;
            PG8_LDA(At, 1, 1); PG8_STAGE(PG8_SA(1, 0), a3, voffA);
            PG8_BAR; PG8_WAIT_L(0); PG8_MMA(1, 0, At, B0); PG8_BAR; PG8_SCHED;
            PG8_STAGE(PG8_SB(1, 1), b3 + hstep, voffB);
            PG8_WAIT_V(6); PG8_BAR; PG8_MMA(1, 1, At, B1); PG8_BAR;
            }
        }
        if constexpr (ALIGN_EPI) { if (wr == 0) PG8_BAR; }
        if constexpr (!Epi::AFTER_DRAIN) { E(acc, cur, wr, wc, fr, fq); S.done(cur); }
        if (!has_next) break;
#pragma unroll
        for (int a = 0; a < 2; ++a)
#pragma unroll
            for (int b = 0; b < 2; ++b)
#pragma unroll
                for (int m = 0; m < 4; ++m)
#pragma unroll
                    for (int n = 0; n < 2; ++n) acc[a][b][m][n] = (f32x4){0.f, 0.f, 0.f, 0.f};
        cur = nxt; cA = nA; cB = nB; ++ui;
        if constexpr (ALIGN_EPI) { if (wr == 1) PG8_BAR; }
    }
    PG8_WAIT_V(0);
    if constexpr (!ALIGN_EPI) { if (wr == 0) PG8_BAR; }
    PG8_BAR;
    if constexpr (Epi::AFTER_DRAIN) { E.fused(acc, cur, wr, wc, fr, fq, lds, wid, lane); S.done(cur); }
#undef PG8_SA
#undef PG8_SB
#undef PG8_STAGE
#undef PG8_LDA
#undef PG8_LDB
#undef PG8_MMA
#undef PG8_WAIT_V
#undef PG8_WAIT_L
#undef PG8_BAR
#undef PG8_SCHED
}
}

#define LAS __attribute__((address_space(3)))
typedef unsigned short bf16_t;
typedef short bf16x8 __attribute__((ext_vector_type(8)));
typedef short s16x4 __attribute__((ext_vector_type(4)));
typedef float f32x4 __attribute__((ext_vector_type(4)));
typedef float f32x16 __attribute__((ext_vector_type(16)));
typedef unsigned u32x4 __attribute__((ext_vector_type(4)));
typedef unsigned u32x2 __attribute__((ext_vector_type(2)));

constexpr int DM = 1024, SEQ = 8192, NBATCH = 2, CTXL = 256, DEPTH = 4, DFF = 4096, INW = 6144;
constexpr int ML = NBATCH * SEQ, MC = NBATCH * CTXL, MT = ML + MC;
constexpr int NKV = SEQ + CTXL;
constexpr int NTHREADS = 512, NWAVES = 8;
constexpr int LDS_BYTES = 147456;
constexpr float C2 = 0.125f * 1.4426950408889634f;
constexpr float LOG2E = 1.4426950408889634f;

constexpr size_t MiB = 1u << 20;
constexpr size_t WS_ROPE = 0;
constexpr size_t WS_BAR = 16384;
constexpr size_t WS_LAM = 32768;
constexpr size_t WS_MOD = 65536;
constexpr size_t WS_WIN = 1 * MiB;
constexpr size_t WS_WBR = WS_WIN + (size_t)INW * DM * 2;
constexpr size_t WS_WOUT = WS_WBR + (size_t)3 * DM * 512 * 2;
constexpr size_t WS_WF1 = WS_WOUT + (size_t)DM * DM * 2;
constexpr size_t WS_WF2 = WS_WF1 + (size_t)DFF * DM * 2;
constexpr size_t WS_Y = 34 * MiB;
constexpr size_t WS_H = 36 * MiB;
constexpr size_t WS_O = 69 * MiB;
constexpr size_t WS_R = 119 * MiB;
constexpr size_t QSZ = (size_t)MT * 512 * 2;
constexpr size_t R_QA = 0, R_QB = QSZ, R_QC = 2 * QSZ, R_KA = 3 * QSZ;
constexpr size_t KSM = (size_t)NBATCH * NKV * 128 * 2;
constexpr size_t R_KB = R_KA + QSZ, R_KC = R_KB + KSM, R_VTA = R_KC + KSM, R_VTB = R_VTA + QSZ, R_VTC = R_VTB + KSM, R_G = R_VTC + KSM;
constexpr size_t R_T12 = 0, R_U = 0, R_T3 = 132 * MiB;
constexpr size_t WS_TCO = WS_R + 198 * MiB;
constexpr size_t WS_TCF = WS_TCO + 16 * MiB;
constexpr size_t WS_SCR = WS_TCF + 16 * MiB;
constexpr size_t WS_END = WS_SCR;
static_assert(WS_WF2 + (size_t)DM * DFF * 2 <= WS_Y, "weights fit");
static_assert(R_G == 99 * MiB, "overlay map");
static_assert(R_G + (size_t)MT * 3072 * 2 == 198 * MiB, "overlay map G");

struct Args { const float* in[23]; float* out; unsigned char* ws; };
enum { I_X = 0, I_C, I_CTX, I_CCTX, I_WADA, I_BADA, I_GPREMIX, I_GPOSTMIX, I_GPREFF, I_GPOSTFF, I_WIN, I_GQ, I_GK, I_LQ1, I_LK1, I_LQ2, I_LK2, I_GSUB, I_SINK, I_WBR, I_WOUT, I_WF1, I_WF2 };

__device__ __forceinline__ const float* inp(int i) { asm volatile("" : "+s"(i)); return ((const float* const*)__builtin_amdgcn_kernarg_segment_ptr())[i]; }
__device__ __forceinline__ float* outp() { return (float*)inp(23); }
__device__ __forceinline__ unsigned char* wsp() { return (unsigned char*)inp(24); }
typedef float f32x2_t __attribute__((ext_vector_type(2))); typedef __bf16 bf16x2_t __attribute__((ext_vector_type(2)));
__device__ __forceinline__ unsigned cvtpk(float lo, float hi) { const f32x2_t v = {lo, hi}; const bf16x2_t b = __builtin_convertvector(v, bf16x2_t); return __builtin_bit_cast(unsigned, b); }
__device__ __forceinline__ float bf_lo(unsigned u) { return __uint_as_float(u << 16); }
__device__ __forceinline__ float bf_hi(unsigned u) { return __uint_as_float(u & 0xffff0000u); }
__device__ __forceinline__ unsigned short f2bf(float f) { return (unsigned short)(cvtpk(f, f) & 0xffffu); }
__device__ __forceinline__ float wave_sum(float v) {
#pragma unroll
    for (int o = 1; o < 64; o <<= 1) v += __shfl_xor(v, o);
    return v;
}
__device__ __forceinline__ int otid() { int t = threadIdx.x; asm volatile("" : "+v"(t)); return t; }
__device__ __forceinline__ int obx() { int b = blockIdx.x; asm volatile("" : "+s"(b)); return b; }
__device__ __forceinline__ float lam_init_of(int l) { return l == 0 ? 0.2f : (l == 1 ? 0.35550906759096926f : (l == 2 ? 0.47071301834358416f : 0.5560582041556405f)); }

struct EpiG1 {
    static constexpr bool PERM = false, AFTER_DRAIN = false;
    unsigned char* R; const float *rope, *gq, *gk;
    __device__ __forceinline__ void operator()(const f32x4 (&acc)[2][2][4][2], const pg8::Unit& u, int wr, int wc, int fr_, int fq_) const {
        int fr = fr_, fq = fq_; asm volatile("" : "+v"(fr), "+v"(fq));
        bf16_t* const QA = (bf16_t*)(R + R_QA); bf16_t* const QB = (bf16_t*)(R + R_QB); bf16_t* const QC = (bf16_t*)(R + R_QC);
        bf16_t* const KA = (bf16_t*)(R + R_KA); bf16_t* const KB = (bf16_t*)(R + R_KB); bf16_t* const KC = (bf16_t*)(R + R_KC);
        bf16_t* const VTA = (bf16_t*)(R + R_VTA); bf16_t* const VTB = (bf16_t*)(R + R_VTB); bf16_t* const VTC = (bf16_t*)(R + R_VTC); bf16_t* const G = (bf16_t*)(R + R_G);
        const int pm = u.pm, pn = u.pn;
        const bool lat = pm < 64;
        const int b = lat ? (pm >> 5) : (pm - 64);
        const int kvb = lat ? ((pm & 31) << 8) : SEQ;
        const int rl0 = wr * 64 + fr;
        if (pn < 9) {
            const int s = pn * 4 + wc;
            bf16_t* dst; int pitch; bool isK = false; float scale = 1.f; const float* gain = nullptr;
            if (s < 8) { dst = QA + s * 64; pitch = 512; scale = C2; }
            else if (s < 16) { dst = KA + (size_t)b * NKV * 512 + (s - 8) * 64; pitch = 512; isK = true; }
            else if (s < 24) { dst = QB + (s - 16) * 64; pitch = 512; scale = C2; gain = gq; }
            else if (s < 32) { dst = QC + (s - 24) * 64; pitch = 512; scale = C2; }
            else if (s < 34) { dst = KB + (size_t)b * NKV * 128 + (s - 32) * 64; pitch = 128; isK = true; gain = gk; }
            else { dst = KC + (size_t)b * NKV * 128 + (s - 34) * 64; pitch = 128; isK = true; }
            const size_t rbase = isK ? (size_t)kvb : (size_t)pm * 256;
#pragma unroll
            for (int ai = 0; ai < 2; ++ai)
#pragma unroll
                for (int m = 0; m < 4; ++m) {
                    const int rl = ai * 128 + rl0 + m * 16;
                    f32x4 v[2][2];
#pragma unroll
                    for (int bj = 0; bj < 2; ++bj)
#pragma unroll
                        for (int n = 0; n < 2; ++n) v[bj][n] = acc[ai][bj][m][n];
                    if (gain) {
                        float ss = 0.f;
#pragma unroll
                        for (int bj = 0; bj < 2; ++bj)
#pragma unroll
                            for (int n = 0; n < 2; ++n) { const f32x4 x = v[bj][n]; ss += (x[0] * x[0] + x[1] * x[1]) + (x[2] * x[2] + x[3] * x[3]); }
                        ss += __shfl_xor(ss, 16); ss += __shfl_xor(ss, 32);
                        const float rstd = rsqrtf(ss * (1.f / 64.f) + 1e-6f);
#pragma unroll
                        for (int bj = 0; bj < 2; ++bj)
#pragma unroll
                            for (int n = 0; n < 2; ++n) { const f32x4 g4 = *(const f32x4*)(gain + 32 * bj + 16 * n + 4 * fq); v[bj][n] = v[bj][n] * rstd * g4; }
                    }
                    if (lat) {
                        const int t = kvb + rl;
#pragma unroll
                        for (int bj = 0; bj < 2; ++bj) {
                            const int pos = bj ? (t & 63) : (t >> 6);
                            const f32x4 cs = *(const f32x4*)(rope + pos * 32 + 4 * fq), sn = *(const f32x4*)(rope + pos * 32 + 16 + 4 * fq);
                            const f32x4 x1 = v[bj][0], x2 = v[bj][1];
                            v[bj][0] = x1 * cs - x2 * sn; v[bj][1] = x2 * cs + x1 * sn;
                        }
                    }
                    bf16_t* rowp = dst + (rbase + rl) * pitch + 4 * fq;
#pragma unroll
                    for (int bj = 0; bj < 2; ++bj)
#pragma unroll
                        for (int n = 0; n < 2; ++n) { const f32x4 x = v[bj][n] * scale; u32x2 w; w.x = cvtpk(x[0], x[1]); w.y = cvtpk(x[2], x[3]); *(u32x2*)(rowp + 32 * bj + 16 * n) = w; }
                }
        } else if (pn < 12) {
#pragma unroll
            for (int bj = 0; bj < 2; ++bj) {
                bf16_t* vt; int vrow0;
                if (pn < 11) { vt = VTA + (size_t)b * 512 * NKV; vrow0 = (pn - 9) * 256 + 128 * bj + 32 * wc + 4 * fq; }
                else { vt = (bj == 0 ? VTB : VTC) + (size_t)b * 128 * NKV; vrow0 = 32 * wc + 4 * fq; }
#pragma unroll
                for (int n = 0; n < 2; ++n)
#pragma unroll
                    for (int j = 0; j < 4; ++j) {
                        bf16_t* colp = vt + (size_t)(vrow0 + 16 * n + j) * NKV + kvb + rl0;
#pragma unroll
                        for (int ai = 0; ai < 2; ++ai)
#pragma unroll
                            for (int m = 0; m < 4; ++m) colp[ai * 128 + m * 16] = f2bf(acc[ai][bj][m][n][j]);
                    }
            }
        } else {
            const int g0 = (pn - 12) * 256 + 32 * wc + 4 * fq;
#pragma unroll
            for (int ai = 0; ai < 2; ++ai)
#pragma unroll
                for (int m = 0; m < 4; ++m) {
                    unsigned char* rowp = (unsigned char*)G + ((size_t)pm * 256 + ai * 128 + rl0 + m * 16) * 3072 + g0;
#pragma unroll
                    for (int bj = 0; bj < 2; ++bj)
#pragma unroll
                        for (int n = 0; n < 2; ++n) {
                            const f32x4 x = acc[ai][bj][m][n]; f32x4 y;
#pragma unroll
                            for (int j = 0; j < 4; ++j) y[j] = __builtin_amdgcn_rcpf(1.f + __expf(-x[j]));
                            const unsigned w = (unsigned)(y[0] * 255.f + 0.5f) | ((unsigned)(y[1] * 255.f + 0.5f) << 8) | ((unsigned)(y[2] * 255.f + 0.5f) << 16) | ((unsigned)(y[3] * 255.f + 0.5f) << 24);
                            *(unsigned*)(rowp + 128 * bj + 16 * n) = w;
                        }
                }
        }
    }
};

template <int STEP> struct EpiMerge {
    static constexpr bool PERM = true, AFTER_DRAIN = false;
    const bf16_t* G; bf16_t* T; bf16_t* Z;
    __device__ __forceinline__ void operator()(const f32x4 (&acc)[2][2][4][2], const pg8::Unit& u, int wr, int wc, int fr, int fq) const {
        const int row0 = u.pm * 256 + wr * 64 + fr, col0 = u.pn * 256 + wc * 32 + 8 * fq;
#pragma unroll
        for (int ai = 0; ai < 2; ++ai)
#pragma unroll
            for (int m = 0; m < 4; ++m) {
                const size_t r = (size_t)(row0 + ai * 128 + m * 16);
#pragma unroll
                for (int bj = 0; bj < 2; ++bj) {
                    const int c = col0 + 128 * bj;
                    const u32x2 g = *(const u32x2*)((const unsigned char*)G + r * 3072 + STEP * 1024 + c);
                    f32x4 v0 = acc[ai][bj][m][0], v1 = acc[ai][bj][m][1];
                    constexpr float S8 = 1.f / 255.f;
                    v0 = v0 * ((f32x4){(float)(g.x & 255u), (float)((g.x >> 8) & 255u), (float)((g.x >> 16) & 255u), (float)(g.x >> 24)} * S8);
                    v1 = v1 * ((f32x4){(float)(g.y & 255u), (float)((g.y >> 8) & 255u), (float)((g.y >> 16) & 255u), (float)(g.y >> 24)} * S8);
                    bf16_t* tp = (STEP < 2 ? T : Z) + r * 1024 + c;
                    if (STEP > 0) { const u32x4 t = *(const u32x4*)(T + r * 1024 + c);
                        v0 = v0 + (f32x4){bf_lo(t.x), bf_hi(t.x), bf_lo(t.y), bf_hi(t.y)}; v1 = v1 + (f32x4){bf_lo(t.z), bf_hi(t.z), bf_lo(t.w), bf_hi(t.w)}; }
                    u32x4 w; w.x = cvtpk(v0[0], v0[1]); w.y = cvtpk(v0[2], v0[3]); w.z = cvtpk(v1[0], v1[1]); w.w = cvtpk(v1[2], v1[3]); *(u32x4*)tp = w;
                }
            }
    }
};
struct EpiF32 {
    static constexpr bool PERM = false, AFTER_DRAIN = false;
    float* T; int ldc;
    __device__ __forceinline__ void operator()(const f32x4 (&acc)[2][2][4][2], const pg8::Unit& u, int wr, int wc, int fr, int fq) const {
        const int row0 = u.pm * 256 + wr * 64 + fr, col0 = u.pn * 256 + wc * 32 + 4 * fq;
#pragma unroll
        for (int ai = 0; ai < 2; ++ai)
#pragma unroll
            for (int m = 0; m < 4; ++m) {
                float* rowp = T + (size_t)(row0 + ai * 128 + m * 16) * ldc + col0;
#pragma unroll
                for (int bj = 0; bj < 2; ++bj)
#pragma unroll
                    for (int n = 0; n < 2; ++n) *(f32x4*)(rowp + 128 * bj + 16 * n) = acc[ai][bj][m][n];
            }
    }
};
struct CtxSplitOrder {
    pg8::StaticOrder S; int G, c, nl, ksplit, klen, npieces;
    __device__ void init(int N, int K, int G_, int c_, bool with_ctx) { S.init(ML, N, G_, c_); G = G_; c = c_; const int nwg = (ML / 256) * (N / 256); nl = c < nwg ? (nwg - c + G - 1) / G : 0;
        ksplit = 8; klen = K / 8; npieces = with_ctx ? (MC / 256) * (N / 256) * ksplit : 0; }
    __device__ bool next(int i, pg8::Unit& u) const {
        if (i < nl) return S.next(i, u);
        const int q = (i - nl) * G + c; if (q >= npieces) return false;
        const int tile = q / ksplit, kc = q % ksplit; u.pm = ML / 256 + (tile >> 2); u.pn = tile & 3; u.koff = kc * klen; u.nt = klen / 64; return true;
    }
    __device__ __forceinline__ void a_ready(const pg8::Unit&) const {}
    __device__ __forceinline__ void done(const pg8::Unit&) const {}
};
struct EpiF32Split {
    static constexpr bool PERM = false, AFTER_DRAIN = false;
    float* T; float* TC; int klen;
    __device__ __forceinline__ void operator()(const f32x4 (&acc)[2][2][4][2], const pg8::Unit& u, int wr, int wc, int fr, int fq) const {
        const int col0 = u.pn * 256 + wc * 32 + 4 * fq;
        if (u.pm < ML / 256) {
            const int row0 = u.pm * 256 + wr * 64 + fr;
#pragma unroll
            for (int ai = 0; ai < 2; ++ai)
#pragma unroll
                for (int m = 0; m < 4; ++m) {
                    float* rowp = T + (size_t)(row0 + ai * 128 + m * 16) * DM + col0;
#pragma unroll
                    for (int bj = 0; bj < 2; ++bj)
#pragma unroll
                        for (int n = 0; n < 2; ++n) *(f32x4*)(rowp + 128 * bj + 16 * n) = acc[ai][bj][m][n];
                }
        } else {
            const int row0 = (u.pm - ML / 256) * 256 + wr * 64 + fr;
#pragma unroll
            for (int ai = 0; ai < 2; ++ai)
#pragma unroll
                for (int m = 0; m < 4; ++m) {
                    float* rowp = TC + ((size_t)(u.koff / klen) * MC + row0 + ai * 128 + m * 16) * DM + col0;
#pragma unroll
                    for (int bj = 0; bj < 2; ++bj)
#pragma unroll
                        for (int n = 0; n < 2; ++n) *(f32x4*)(rowp + 128 * bj + 16 * n) = acc[ai][bj][m][n];
                }
        }
    }
};
struct EpiSqRelu {
    static constexpr bool PERM = true, AFTER_DRAIN = false;
    bf16_t* U; int ldc;
    __device__ __forceinline__ void operator()(const f32x4 (&acc)[2][2][4][2], const pg8::Unit& u, int wr, int wc, int fr, int fq) const {
        const int row0 = u.pm * 256 + wr * 64 + fr, col0 = u.pn * 256 + wc * 32 + 8 * fq;
#pragma unroll
        for (int ai = 0; ai < 2; ++ai)
#pragma unroll
            for (int m = 0; m < 4; ++m) {
                bf16_t* rowp = U + (size_t)(row0 + ai * 128 + m * 16) * ldc + col0;
#pragma unroll
                for (int bj = 0; bj < 2; ++bj) {
                    f32x4 v0 = acc[ai][bj][m][0], v1 = acc[ai][bj][m][1];
#pragma unroll
                    for (int j = 0; j < 4; ++j) { const float a = fmaxf(v0[j], 0.f), c = fmaxf(v1[j], 0.f); v0[j] = a * a; v1[j] = c * c; }
                    u32x4 w; w.x = cvtpk(v0[0], v0[1]); w.y = cvtpk(v0[2], v0[3]); w.z = cvtpk(v1[0], v1[1]); w.w = cvtpk(v1[2], v1[3]);
                    *(u32x4*)(rowp + 128 * bj) = w;
                }
            }
    }
};

constexpr int KP = 72, VP = 72;
constexpr int KBUFB = 64 * KP * 2, VBUFB = 128 * VP * 2, ABUFB = KBUFB + VBUFB;

template <int DV>
__device__ __forceinline__ void attn_pass(f32x16 (&o)[DV / 32], const bf16_t* qrow, const bf16_t* Kb, int kpitch, const bf16_t* Vtb,
                                          int s0a, int s0b, int s1a, int s1b, bool has_sink, float m_init, float l_init, bool win, int qpos, int qw0, LAS unsigned char* lds) {
    const int tid = otid(), lane = tid & 63, r32 = lane & 31, hi = lane >> 5;
    bf16x8 qf[4];
#pragma unroll
    for (int d0 = 0; d0 < 4; ++d0) qf[d0] = *(const bf16x8*)(qrow + 16 * d0 + 8 * hi);
    asm volatile("" : "+v"(qf[0]), "+v"(qf[1]), "+v"(qf[2]), "+v"(qf[3]));
#pragma unroll
    for (int i = 0; i < DV / 32; ++i)
#pragma unroll
        for (int r = 0; r < 16; ++r) o[i][r] = 0.f;
    float mref = has_sink ? m_init : 0.f, lrun = l_init;
    bool first = !has_sink;
    f32x16 negm;
#pragma unroll
    for (int r = 0; r < 16; ++r) negm[r] = -mref;
    const int n0 = (s0b - s0a) >> 6, nt = n0 + ((s1b - s1a) >> 6);
    const int lrow = tid >> 3, lch = tid & 7;
    const bf16_t* kg = Kb + (size_t)lrow * kpitch + lch * 8;
    const bf16_t* vg = Vtb + (size_t)lrow * NKV + lch * 8;
    const int prow = (lrow & ~12) | ((lrow & 4) << 1) | ((lrow & 8) >> 1);
    const unsigned kst = (unsigned)((prow * KP + lch * 8) * 2), vst = (unsigned)(KBUFB + (lrow * VP + lch * 8) * 2);
    u32x4 kr, vr0, vr1;
    {
        const int k0 = (0 < n0) ? s0a : s1a;
        kr = *(const u32x4*)(kg + (size_t)k0 * kpitch); vr0 = *(const u32x4*)(vg + k0);
        if (DV == 128) vr1 = *(const u32x4*)(vg + (size_t)64 * NKV + k0);
        *(LAS u32x4*)(lds + kst) = kr;
        *(LAS u32x4*)(lds + vst) = vr0;
        if (DV == 128) *(LAS u32x4*)(lds + vst + 64 * VP * 2) = vr1;
    }
    __syncthreads();
    for (int t = 0; t < nt; ++t) {
        const int k0 = (t < n0) ? (s0a + (t << 6)) : (s1a + ((t - n0) << 6));
        const bool more = (t + 1 < nt);
        if (more) {
            const int k1 = (t + 1 < n0) ? (s0a + ((t + 1) << 6)) : (s1a + ((t + 1 - n0) << 6));
            kr = *(const u32x4*)(kg + (size_t)k1 * kpitch); vr0 = *(const u32x4*)(vg + k1);
            if (DV == 128) vr1 = *(const u32x4*)(vg + (size_t)64 * NKV + k1);
        }
        const LAS unsigned char* Kl = lds + (t & 1) * ABUFB;
        const LAS unsigned char* Vl = Kl + KBUFB;
        const bool masked = win && (t < n0);
        const bool skip = masked && ((k0 + 63 < qw0 - 128) || (k0 > qw0 + 31 + 128));
        if (!skip) {
            f32x16 p0, p1;
            {
                bf16x8 kf[8];
#pragma unroll
                for (int d0 = 0; d0 < 4; ++d0) {
                    kf[2 * d0] = *(const LAS bf16x8*)(Kl + (r32 * KP + 16 * d0 + 8 * hi) * 2);
                    kf[2 * d0 + 1] = *(const LAS bf16x8*)(Kl + ((32 + r32) * KP + 16 * d0 + 8 * hi) * 2);
                }
                __builtin_amdgcn_sched_barrier(0);
                p0 = __builtin_amdgcn_mfma_f32_32x32x16_bf16(kf[0], qf[0], negm, 0, 0, 0); p1 = __builtin_amdgcn_mfma_f32_32x32x16_bf16(kf[1], qf[0], negm, 0, 0, 0);
#pragma unroll
                for (int d0 = 1; d0 < 4; ++d0) { p0 = __builtin_amdgcn_mfma_f32_32x32x16_bf16(kf[2 * d0], qf[d0], p0, 0, 0, 0); p1 = __builtin_amdgcn_mfma_f32_32x32x16_bf16(kf[2 * d0 + 1], qf[d0], p1, 0, 0, 0); }
                __builtin_amdgcn_sched_barrier(0);
            }
            bf16x8 vfa[8];
#pragma unroll
            for (int db = 0; db < 2; ++db)
#pragma unroll
                for (int c = 0; c < 4; ++c) vfa[db * 4 + c] = *(const LAS bf16x8*)(Vl + ((32 * db + r32) * VP + 16 * c + 8 * hi) * 2);
            if (masked) {
#pragma unroll
                for (int r = 0; r < 16; ++r) {
                    const int kv = k0 + 16 * (r >> 3) + 8 * hi + 4 * ((r >> 2) & 1) + (r & 3);
                    int d0 = kv - qpos; d0 = d0 < 0 ? -d0 : d0; int d1 = kv + 32 - qpos; d1 = d1 < 0 ? -d1 : d1;
                    if (d0 > 128) p0[r] = -1e30f;
                    if (d1 > 128) p1[r] = -1e30f;
                }
            }
#define MX3(a, b, c) __builtin_fmaxf(__builtin_fmaxf((a), (b)), (c))
            float ma = MX3(p0[0], p0[1], p1[0]), mb = MX3(p0[2], p0[3], p1[1]); ma = MX3(ma, p1[2], p1[3]);
#pragma unroll
            for (int r = 4; r < 16; r += 4) { ma = MX3(ma, p0[r], p0[r + 1]); mb = MX3(mb, p0[r + 2], p0[r + 3]); ma = MX3(ma, p1[r], p1[r + 1]); mb = MX3(mb, p1[r + 2], p1[r + 3]); }
#undef MX3
            float mx = fmaxf(ma, mb);
            mx = fmaxf(mx, __shfl_xor(mx, 32));
            if (first || __any(mx > 8.f)) {
                const float dl = first ? mx : fmaxf(mx, 0.f);
                const float alpha = first ? 1.f : __builtin_amdgcn_exp2f(-dl);
                mref += dl; lrun *= alpha;
#pragma unroll
                for (int r = 0; r < 16; ++r) { p0[r] -= dl; p1[r] -= dl; negm[r] = -mref; }
#pragma unroll
                for (int i = 0; i < DV / 32; ++i)
#pragma unroll
                    for (int r = 0; r < 16; ++r) o[i][r] *= alpha;
                first = false;
            }
            float rs0 = 0.f, rs1 = 0.f;
#pragma unroll
            for (int r = 0; r < 16; ++r) { p0[r] = __builtin_amdgcn_exp2f(p0[r]); p1[r] = __builtin_amdgcn_exp2f(p1[r]); rs0 += p0[r]; rs1 += p1[r]; }
            lrun += rs0 + rs1;
            bf16x8 pk[4];
            { u32x4 w;
              w.x = cvtpk(p0[0], p0[1]); w.y = cvtpk(p0[2], p0[3]); w.z = cvtpk(p0[4], p0[5]); w.w = cvtpk(p0[6], p0[7]); pk[0] = __builtin_bit_cast(bf16x8, w);
              w.x = cvtpk(p0[8], p0[9]); w.y = cvtpk(p0[10], p0[11]); w.z = cvtpk(p0[12], p0[13]); w.w = cvtpk(p0[14], p0[15]); pk[1] = __builtin_bit_cast(bf16x8, w);
              w.x = cvtpk(p1[0], p1[1]); w.y = cvtpk(p1[2], p1[3]); w.z = cvtpk(p1[4], p1[5]); w.w = cvtpk(p1[6], p1[7]); pk[2] = __builtin_bit_cast(bf16x8, w);
              w.x = cvtpk(p1[8], p1[9]); w.y = cvtpk(p1[10], p1[11]); w.z = cvtpk(p1[12], p1[13]); w.w = cvtpk(p1[14], p1[15]); pk[3] = __builtin_bit_cast(bf16x8, w); }
            __builtin_amdgcn_sched_barrier(0);
            if (DV == 128) {
                bf16x8 vfb[8];
#pragma unroll
                for (int db = 2; db < 4; ++db)
#pragma unroll
                    for (int c = 0; c < 4; ++c) vfb[(db - 2) * 4 + c] = *(const LAS bf16x8*)(Vl + ((32 * db + r32) * VP + 16 * c + 8 * hi) * 2);
#pragma unroll
                for (int db = 0; db < 2; ++db)
#pragma unroll
                    for (int c = 0; c < 4; ++c) {
                        o[db] = __builtin_amdgcn_mfma_f32_32x32x16_bf16(vfa[db * 4 + c], pk[c], o[db], 0, 0, 0);
                    }
                __builtin_amdgcn_sched_barrier(0);
#pragma unroll
                for (int db = 2; db < DV / 32; ++db)
#pragma unroll
                    for (int c = 0; c < 4; ++c) {
                        o[db] = __builtin_amdgcn_mfma_f32_32x32x16_bf16(vfb[(db - 2) * 4 + c], pk[c], o[db], 0, 0, 0);
                    }
            } else {
#pragma unroll
                for (int db = 0; db < 2; ++db)
#pragma unroll
                    for (int c = 0; c < 4; ++c) {
                        o[db] = __builtin_amdgcn_mfma_f32_32x32x16_bf16(vfa[db * 4 + c], pk[c], o[db], 0, 0, 0);
                    }
            }
            __builtin_amdgcn_sched_barrier(0);
        }
        if (more) {
            const unsigned bo = ((t + 1) & 1) * ABUFB;
            *(LAS u32x4*)(lds + bo + kst) = kr;
            *(LAS u32x4*)(lds + bo + vst) = vr0;
            if (DV == 128) *(LAS u32x4*)(lds + bo + vst + 64 * VP * 2) = vr1;
        }
        __syncthreads();
    }
    const float lt = lrun + __shfl_xor(lrun, 32);
    const float inv = 1.f / lt;
#pragma unroll
    for (int i = 0; i < DV / 32; ++i)
#pragma unroll
        for (int r = 0; r < 16; ++r) o[i][r] *= inv;
}

__device__ __forceinline__ void attn_pass2(f32x16 (&o)[2][2], const bf16_t* qrow0  , const bf16_t* Kb, const bf16_t* Vtb,
                                           int s0a, int s0b, int s1a, int s1b, bool has_sink, float m_init0, float m_init1, float l_init, bool win, int qpos, int qw0, LAS unsigned char* lds) {
    const int tid = otid(), lane = tid & 63, r32 = lane & 31, hi = lane >> 5;
    constexpr int kpitch = 128;
    bf16x8 qf[2][4];
#pragma unroll
    for (int rb = 0; rb < 2; ++rb)
#pragma unroll
        for (int d0 = 0; d0 < 4; ++d0) qf[rb][d0] = *(const bf16x8*)(qrow0 + 64 * rb + 16 * d0 + 8 * hi);
    asm volatile("" : "+v"(qf[0][0]), "+v"(qf[0][1]), "+v"(qf[0][2]), "+v"(qf[0][3]), "+v"(qf[1][0]), "+v"(qf[1][1]), "+v"(qf[1][2]), "+v"(qf[1][3]));
#pragma unroll
    for (int rb = 0; rb < 2; ++rb)
#pragma unroll
        for (int i = 0; i < 2; ++i)
#pragma unroll
            for (int r = 0; r < 16; ++r) o[rb][i][r] = 0.f;
    float mref[2] = {has_sink ? m_init0 : 0.f, has_sink ? m_init1 : 0.f}, lrun[2] = {l_init, l_init};
    bool first = !has_sink;
    const int n0 = (s0b - s0a) >> 6, nt = n0 + ((s1b - s1a) >> 6);
#define LANE_ADDR() const int tl_ = otid(); const int lrow = tl_ >> 3, lch = tl_ & 7; const bf16_t* kg = Kb + (size_t)lrow * kpitch + lch * 8; const bf16_t* vg = Vtb + (size_t)lrow * NKV + lch * 8; \
        const int prow_ = (lrow & ~12) | ((lrow & 4) << 1) | ((lrow & 8) >> 1); \
        const unsigned kst = (unsigned)((prow_ * KP + lch * 8) * 2), vst = (unsigned)(KBUFB + (lrow * VP + lch * 8) * 2)
#define TILE_K0(t) (((t) < n0) ? (s0a + ((t) << 6)) : (s1a + (((t) - n0) << 6)))
    u32x4 kr, vr0;
    { LANE_ADDR(); const int k0 = TILE_K0(0); kr = *(const u32x4*)(kg + (size_t)k0 * kpitch); vr0 = *(const u32x4*)(vg + k0);
      *(LAS u32x4*)(lds + kst) = kr; *(LAS u32x4*)(lds + vst) = vr0; }
    __syncthreads();
    for (int t = 0; t < nt; ++t) {
        const int k0 = TILE_K0(t);
        const bool more = (t + 1 < nt);
        if (more) { LANE_ADDR(); const int k1 = TILE_K0(t + 1); kr = *(const u32x4*)(kg + (size_t)k1 * kpitch); vr0 = *(const u32x4*)(vg + k1); }
        const LAS unsigned char* Kl = lds + (t & 1) * ABUFB;
        const LAS unsigned char* Vl = Kl + KBUFB;
        const bool masked = win && (t < n0);
        const bool skip = masked && ((k0 + 63 < qw0 - 128) || (k0 > qw0 + 31 + 128));
        if (!skip) {
            f32x16 p[2][2];
            {
                const f32x16 z = {0.f, 0.f, 0.f, 0.f, 0.f, 0.f, 0.f, 0.f, 0.f, 0.f, 0.f, 0.f, 0.f, 0.f, 0.f, 0.f};
#pragma unroll
                for (int g = 0; g < 2; ++g) {
                    bf16x8 kf[4];
#pragma unroll
                    for (int d = 0; d < 2; ++d) {
                        kf[2 * d] = *(const LAS bf16x8*)(Kl + (r32 * KP + 16 * (2 * g + d) + 8 * hi) * 2);
                        kf[2 * d + 1] = *(const LAS bf16x8*)(Kl + ((32 + r32) * KP + 16 * (2 * g + d) + 8 * hi) * 2);
                    }
                    __builtin_amdgcn_sched_barrier(0);
#pragma unroll
                    for (int rb = 0; rb < 2; ++rb)
#pragma unroll
                        for (int d = 0; d < 2; ++d) {
                            if (g == 0 && d == 0) { p[rb][0] = __builtin_amdgcn_mfma_f32_32x32x16_bf16(kf[0], qf[rb][0], z, 0, 0, 0); p[rb][1] = __builtin_amdgcn_mfma_f32_32x32x16_bf16(kf[1], qf[rb][0], z, 0, 0, 0); }
                            else { p[rb][0] = __builtin_amdgcn_mfma_f32_32x32x16_bf16(kf[2 * d], qf[rb][2 * g + d], p[rb][0], 0, 0, 0); p[rb][1] = __builtin_amdgcn_mfma_f32_32x32x16_bf16(kf[2 * d + 1], qf[rb][2 * g + d], p[rb][1], 0, 0, 0); }
                        }
                    __builtin_amdgcn_sched_barrier(0);
                }
            }
            bf16x8 pk[2][4];
            const bool domask = masked && !((k0 >= qw0 + 31 - 128) && (k0 + 63 <= qw0 + 128));
            const int ub = k0 - qpos + 128 + 8 * hi;
#define MX3(a, b, c) __builtin_fmaxf(__builtin_fmaxf((a), (b)), (c))
#pragma unroll
            for (int rb = 0; rb < 2; ++rb) {
                f32x16& p0 = p[rb][0]; f32x16& p1 = p[rb][1];
                if (domask) {
#pragma unroll
                    for (int r = 0; r < 16; ++r) { const unsigned u0 = (unsigned)(ub + 16 * (r >> 3) + 4 * ((r >> 2) & 1) + (r & 3)); if (u0 > 256u) p0[r] = -1e30f; if (u0 + 32u > 256u) p1[r] = -1e30f; }
                }
                float ma = MX3(p0[0], p0[1], p1[0]), mb = MX3(p0[2], p0[3], p1[1]); ma = MX3(ma, p1[2], p1[3]);
#pragma unroll
                for (int r = 4; r < 16; r += 4) { ma = MX3(ma, p0[r], p0[r + 1]); mb = MX3(mb, p0[r + 2], p0[r + 3]); ma = MX3(ma, p1[r], p1[r + 1]); mb = MX3(mb, p1[r + 2], p1[r + 3]); }
                float mx = fmaxf(ma, mb);
                mx = fmaxf(mx, __shfl_xor(mx, 32)) - mref[rb];
                if (first || __any(mx > 8.f)) {
                    const float dl = first ? mx : fmaxf(mx, 0.f);
                    const float alpha = first ? 1.f : __builtin_amdgcn_exp2f(-dl);
                    mref[rb] += dl; lrun[rb] *= alpha;
#pragma unroll
                    for (int i = 0; i < 2; ++i)
#pragma unroll
                        for (int r = 0; r < 16; ++r) o[rb][i][r] *= alpha;
                }
                const float mr = mref[rb];
                float rs0 = 0.f, rs1 = 0.f;
#pragma unroll
                for (int r = 0; r < 16; ++r) { p0[r] = __builtin_amdgcn_exp2f(p0[r] - mr); p1[r] = __builtin_amdgcn_exp2f(p1[r] - mr); rs0 += p0[r]; rs1 += p1[r]; }
                lrun[rb] += rs0 + rs1;
                u32x4 w;
                w.x = cvtpk(p0[0], p0[1]); w.y = cvtpk(p0[2], p0[3]); w.z = cvtpk(p0[4], p0[5]); w.w = cvtpk(p0[6], p0[7]); pk[rb][0] = __builtin_bit_cast(bf16x8, w);
                w.x = cvtpk(p0[8], p0[9]); w.y = cvtpk(p0[10], p0[11]); w.z = cvtpk(p0[12], p0[13]); w.w = cvtpk(p0[14], p0[15]); pk[rb][1] = __builtin_bit_cast(bf16x8, w);
                w.x = cvtpk(p1[0], p1[1]); w.y = cvtpk(p1[2], p1[3]); w.z = cvtpk(p1[4], p1[5]); w.w = cvtpk(p1[6], p1[7]); pk[rb][2] = __builtin_bit_cast(bf16x8, w);
                w.x = cvtpk(p1[8], p1[9]); w.y = cvtpk(p1[10], p1[11]); w.z = cvtpk(p1[12], p1[13]); w.w = cvtpk(p1[14], p1[15]); pk[rb][3] = __builtin_bit_cast(bf16x8, w);
            }
#undef MX3
            first = false;
#pragma unroll
            for (int db = 0; db < 2; ++db) {
                bf16x8 vfr[4];
#pragma unroll
                for (int c = 0; c < 4; ++c) vfr[c] = *(const LAS bf16x8*)(Vl + ((32 * db + r32) * VP + 16 * c + 8 * hi) * 2);
#pragma unroll
                for (int c = 0; c < 4; ++c) {
                    const bf16x8 vf = vfr[c];
                    o[0][db] = __builtin_amdgcn_mfma_f32_32x32x16_bf16(vf, pk[0][c], o[0][db], 0, 0, 0);
                    o[1][db] = __builtin_amdgcn_mfma_f32_32x32x16_bf16(vf, pk[1][c], o[1][db], 0, 0, 0);
                }
            }
        }
        if (more) { LANE_ADDR(); const unsigned bo = ((t + 1) & 1) * ABUFB; *(LAS u32x4*)(lds + bo + kst) = kr; *(LAS u32x4*)(lds + bo + vst) = vr0; }
        __syncthreads();
    }
#undef TILE_K0
#undef LANE_ADDR
#pragma unroll
    for (int rb = 0; rb < 2; ++rb) {
        const float lt = lrun[rb] + __shfl_xor(lrun[rb], 32);
        const float inv = 1.f / lt;
#pragma unroll
        for (int i = 0; i < 2; ++i)
#pragma unroll
            for (int r = 0; r < 16; ++r) o[rb][i][r] *= inv;
    }
}

__device__ __forceinline__ void attn_pass2b(f32x16 (&o)[2][2], const bf16_t* qrow0, const bf16_t* Kb, const bf16_t* Vtb, int ka, int kb, LAS unsigned char* lds) {
    const int tid = otid(), lane = tid & 63, r32 = lane & 31, hi = lane >> 5;
    constexpr int kpitch = 128;
    LAS bf16x8* ql = (LAS bf16x8*)(lds + 2 * ABUFB) + tid;
    {
        bf16x8 qf[8];
#pragma unroll
        for (int i = 0; i < 8; ++i) qf[i] = *(const bf16x8*)(qrow0 + 64 * (i >> 2) + 16 * (i & 3) + 8 * hi);
#pragma unroll
        for (int i = 0; i < 8; ++i) ql[i * 512] = qf[i];
    }
#pragma unroll
    for (int rb = 0; rb < 2; ++rb)
#pragma unroll
        for (int i = 0; i < 2; ++i)
#pragma unroll
            for (int r = 0; r < 16; ++r) o[rb][i][r] = 0.f;
    float mref = 0.f, lrun[2] = {0.f, 0.f};
    f32x16 negm;
#pragma unroll
    for (int r = 0; r < 16; ++r) negm[r] = 0.f;
    bool first = true;
    const int nt = (kb - ka) >> 6;
#define LANE_ADDR() const int tl_ = otid(); const int lrow = tl_ >> 3, lch = tl_ & 7; const bf16_t* kg = Kb + (size_t)(ka + lrow) * kpitch + lch * 8; const bf16_t* vg = Vtb + (size_t)lrow * NKV + ka + lch * 8; \
        const int prow_ = (lrow & ~12) | ((lrow & 4) << 1) | ((lrow & 8) >> 1); \
        const unsigned kst = (unsigned)((prow_ * KP + lch * 8) * 2), vst = (unsigned)(KBUFB + (lrow * VP + lch * 8) * 2)
    u32x4 kr, vr0;
    { LANE_ADDR(); kr = *(const u32x4*)kg; vr0 = *(const u32x4*)vg; *(LAS u32x4*)(lds + kst) = kr; *(LAS u32x4*)(lds + vst) = vr0; }
    __syncthreads();
    for (int t = 0; t < nt; ++t) {
        const bool more = (t + 1 < nt);
        if (more) { LANE_ADDR(); kr = *(const u32x4*)(kg + (size_t)((t + 1) << 6) * kpitch); vr0 = *(const u32x4*)(vg + ((t + 1) << 6)); }
        const LAS unsigned char* Kl = lds + (t & 1) * ABUFB;
        const LAS unsigned char* Vl = Kl + KBUFB;
        f32x16 p[2][2];
#pragma unroll
        for (int g = 0; g < 2; ++g) {
            bf16x8 kf[4], qq[2][2];
#pragma unroll
            for (int d = 0; d < 2; ++d) {
                kf[2 * d] = *(const LAS bf16x8*)(Kl + (r32 * KP + 16 * (2 * g + d) + 8 * hi) * 2);
                kf[2 * d + 1] = *(const LAS bf16x8*)(Kl + ((32 + r32) * KP + 16 * (2 * g + d) + 8 * hi) * 2);
                qq[0][d] = ql[(2 * g + d) * 512]; qq[1][d] = ql[(4 + 2 * g + d) * 512];
            }
            __builtin_amdgcn_sched_barrier(0);
#pragma unroll
            for (int rb = 0; rb < 2; ++rb)
#pragma unroll
                for (int d = 0; d < 2; ++d) {
                    if (g == 0 && d == 0) { p[rb][0] = __builtin_amdgcn_mfma_f32_32x32x16_bf16(kf[0], qq[rb][0], negm, 0, 0, 0); p[rb][1] = __builtin_amdgcn_mfma_f32_32x32x16_bf16(kf[1], qq[rb][0], negm, 0, 0, 0); }
                    else { p[rb][0] = __builtin_amdgcn_mfma_f32_32x32x16_bf16(kf[2 * d], qq[rb][d], p[rb][0], 0, 0, 0); p[rb][1] = __builtin_amdgcn_mfma_f32_32x32x16_bf16(kf[2 * d + 1], qq[rb][d], p[rb][1], 0, 0, 0); }
                }
            __builtin_amdgcn_sched_barrier(0);
        }
#define MX3(a, b, c) __builtin_fmaxf(__builtin_fmaxf((a), (b)), (c))
        float mx;
        {
            float ma = MX3(p[0][0][0], p[0][0][1], p[0][1][0]), mb = MX3(p[1][0][0], p[1][0][1], p[1][1][0]);
#pragma unroll
            for (int rb = 0; rb < 2; ++rb) {
                const f32x16& p0 = p[rb][0]; const f32x16& p1 = p[rb][1];
                ma = MX3(ma, p0[2], p0[3]); mb = MX3(mb, p1[1], p1[2]); ma = MX3(ma, p1[3], p0[4]);
#pragma unroll
                for (int r = 5; r < 16; r += 2) { ma = MX3(ma, p0[r], p0[r + (r < 15 ? 1 : 0)]); mb = MX3(mb, p1[r - 1], p1[r]); }
            }
            mx = fmaxf(ma, mb);
            mx = fmaxf(mx, __shfl_xor(mx, 32));
        }
#undef MX3
        if (first || __any(mx > 8.f)) {
            const float dl = first ? mx : fmaxf(mx, 0.f);
            const float alpha = first ? 1.f : __builtin_amdgcn_exp2f(-dl);
            mref += dl; lrun[0] *= alpha; lrun[1] *= alpha;
#pragma unroll
            for (int r = 0; r < 16; ++r) negm[r] = -mref;
#pragma unroll
            for (int rb = 0; rb < 2; ++rb) {
#pragma unroll
                for (int r = 0; r < 16; ++r) { p[rb][0][r] -= dl; p[rb][1][r] -= dl; }
#pragma unroll
                for (int i = 0; i < 2; ++i)
#pragma unroll
                    for (int r = 0; r < 16; ++r) o[rb][i][r] *= alpha;
            }
            first = false;
        }
        bf16x8 pk[2][4];
#pragma unroll
        for (int rb = 0; rb < 2; ++rb) {
            f32x16& p0 = p[rb][0]; f32x16& p1 = p[rb][1];
            float rs0 = 0.f, rs1 = 0.f;
#pragma unroll
            for (int r = 0; r < 16; ++r) { p0[r] = __builtin_amdgcn_exp2f(p0[r]); p1[r] = __builtin_amdgcn_exp2f(p1[r]); rs0 += p0[r]; rs1 += p1[r]; }
            lrun[rb] += rs0 + rs1;
            u32x4 w;
            w.x = cvtpk(p0[0], p0[1]); w.y = cvtpk(p0[2], p0[3]); w.z = cvtpk(p0[4], p0[5]); w.w = cvtpk(p0[6], p0[7]); pk[rb][0] = __builtin_bit_cast(bf16x8, w);
            w.x = cvtpk(p0[8], p0[9]); w.y = cvtpk(p0[10], p0[11]); w.z = cvtpk(p0[12], p0[13]); w.w = cvtpk(p0[14], p0[15]); pk[rb][1] = __builtin_bit_cast(bf16x8, w);
            w.x = cvtpk(p1[0], p1[1]); w.y = cvtpk(p1[2], p1[3]); w.z = cvtpk(p1[4], p1[5]); w.w = cvtpk(p1[6], p1[7]); pk[rb][2] = __builtin_bit_cast(bf16x8, w);
            w.x = cvtpk(p1[8], p1[9]); w.y = cvtpk(p1[10], p1[11]); w.z = cvtpk(p1[12], p1[13]); w.w = cvtpk(p1[14], p1[15]); pk[rb][3] = __builtin_bit_cast(bf16x8, w);
        }
#pragma unroll
        for (int db = 0; db < 2; ++db) {
            bf16x8 vfr[4];
#pragma unroll
            for (int c = 0; c < 4; ++c) vfr[c] = *(const LAS bf16x8*)(Vl + ((32 * db + r32) * VP + 16 * c + 8 * hi) * 2);
#pragma unroll
            for (int c = 0; c < 4; ++c) {
                o[0][db] = __builtin_amdgcn_mfma_f32_32x32x16_bf16(vfr[c], pk[0][c], o[0][db], 0, 0, 0);
                o[1][db] = __builtin_amdgcn_mfma_f32_32x32x16_bf16(vfr[c], pk[1][c], o[1][db], 0, 0, 0);
            }
        }
        if (more) { LANE_ADDR(); const unsigned bo = ((t + 1) & 1) * ABUFB; *(LAS u32x4*)(lds + bo + kst) = kr; *(LAS u32x4*)(lds + bo + vst) = vr0; }
        __syncthreads();
    }
#undef LANE_ADDR
#pragma unroll
    for (int rb = 0; rb < 2; ++rb) {
        const float lt = lrun[rb] + __shfl_xor(lrun[rb], 32);
        const float inv = 1.f / lt;
#pragma unroll
        for (int i = 0; i < 2; ++i)
#pragma unroll
            for (int r = 0; r < 16; ++r) o[rb][i][r] *= inv;
    }
}

struct AttnPtrs { unsigned char* R; bf16_t* OA; float* scr; const float *gsub, *sink; const float* lamp; int layer; };

__device__ __forceinline__ void attn_phase(const AttnPtrs& P, bool do_ctx, LAS unsigned char* lds) {
    const int NU = 768 + (do_ctx ? 24 : 0);
    for (int u = obx(); u < NU; u += gridDim.x) {
        const int tid = otid(), lane = tid & 63, r32 = lane & 31, hi = lane >> 5;
        const int wid = __builtin_amdgcn_readfirstlane(tid >> 6);
        int kind, b, h, row0, qp0, s0a, s0b, s1a = SEQ, s1b = SEQ; bool win = false, sinkon = false;
        if (u < 256) { kind = 0; const int bh = u & 7, qb = u >> 3; b = bh >> 2; h = bh & 3; qp0 = qb * 256; row0 = b * SEQ + qp0; s0a = 0; s0b = NKV; }
        else if (u < 768) {
            kind = (u < 512) ? 1 : 2; int qb;
            { const int v = (u - 256) & 255; const int x = v & 7; qb = v >> 3; b = x >> 2; h = 2 * (x & 3); }
            qp0 = qb * 256; row0 = b * SEQ + qp0;
            if (kind == 1) { s0a = 0; s0b = NKV; }
            else { s0a = qp0 - 128 < 0 ? 0 : qp0 - 128; s0b = qp0 + 384 > SEQ ? SEQ : qp0 + 384; s1a = SEQ; s1b = NKV; win = true; sinkon = true; }
        } else {
            const int w = u - 768;
            if (w < 8) { kind = 0; b = w >> 2; h = w & 3; }
            else if (w < 16) { kind = 1; b = (w - 8) >> 2; h = 2 * ((w - 8) & 3); }
            else { kind = 2; b = (w - 16) >> 2; h = 2 * ((w - 16) & 3); sinkon = true; }
            qp0 = 0; row0 = ML + b * CTXL; s0a = SEQ; s0b = NKV;
        }
        const int myrow = row0 + wid * 32 + r32;
        const int qw0 = qp0 + wid * 32, qpos = qw0 + r32;
        if (kind == 0) {
            unsigned o1p[4][8];
#pragma unroll 1
            for (int mp = 0; mp < 2; ++mp) {
                f32x16 o[4];
                attn_pass<128>(o, (const bf16_t*)(P.R + R_QA) + (size_t)myrow * 512 + h * 128 + mp * 64, (const bf16_t*)(P.R + R_KA) + (size_t)b * NKV * 512 + h * 128 + mp * 64, 512,
                               (const bf16_t*)(P.R + R_VTA) + ((size_t)b * 512 + h * 128) * NKV, s0a, s0b, s1a, s1b, false, 0.f, 0.f, false, qpos, qw0, lds);
                if (mp == 0) {
#pragma unroll
                    for (int i = 0; i < 4; ++i)
#pragma unroll
                        for (int k = 0; k < 8; ++k) o1p[i][k] = cvtpk(o[i][2 * k], o[i][2 * k + 1]);
                } else {
                    float ss = 0.f;
                    int ly_ = P.layer; asm volatile("" : "+s"(ly_));
                    const float lam_ = P.lamp[ly_];
#pragma unroll
                    for (int i = 0; i < 4; ++i)
#pragma unroll
                        for (int k = 0; k < 8; ++k) {
                            const float d0 = bf_lo(o1p[i][k]) - lam_ * o[i][2 * k], d1 = bf_hi(o1p[i][k]) - lam_ * o[i][2 * k + 1];
                            o[i][2 * k] = d0; o[i][2 * k + 1] = d1; ss += d0 * d0 + d1 * d1;
                        }
                    ss += __shfl_xor(ss, 32);
                    const float sc = rsqrtf(ss * (1.f / 128.f) + 1e-5f) * (1.f - lam_init_of(ly_));
                    bf16_t* op = P.OA + (size_t)myrow * 512 + h * 128 + 4 * hi;
#pragma unroll
                    for (int i = 0; i < 4; ++i)
#pragma unroll
                        for (int g = 0; g < 4; ++g) {
                            const f32x4 gs = *(const f32x4*)(P.gsub + 32 * i + 8 * g + 4 * hi);
                            u32x2 w; w.x = cvtpk(o[i][4 * g] * sc * gs[0], o[i][4 * g + 1] * sc * gs[1]); w.y = cvtpk(o[i][4 * g + 2] * sc * gs[2], o[i][4 * g + 3] * sc * gs[3]);
                            *(u32x2*)(op + 32 * i + 8 * g) = w;
                        }
                }
            }
        } else {
            const bf16_t* Q = (const bf16_t*)(P.R + (kind == 1 ? R_QB : R_QC)); const bf16_t* K = (const bf16_t*)(P.R + (kind == 1 ? R_KB : R_KC)); const bf16_t* VT = (const bf16_t*)(P.R + (kind == 1 ? R_VTB : R_VTC)); bf16_t* O = P.OA + (size_t)MT * 512 * kind;
            const int kvh = h >> 2;
            if (kind == 1) {
                f32x16 o[2][2];
                attn_pass2b(o, Q + (size_t)myrow * 512 + h * 64, K + (size_t)b * NKV * 128 + kvh * 64, VT + ((size_t)b * 128 + kvh * 64) * NKV, s0a, s0b, lds);
                const int tid2 = otid();
                bf16_t* op = O + (size_t)(row0 + (tid2 >> 6) * 32 + (tid2 & 31)) * 512 + h * 64 + 4 * ((tid2 & 63) >> 5);
#pragma unroll
                for (int rb = 0; rb < 2; ++rb)
#pragma unroll
                    for (int i = 0; i < 2; ++i)
#pragma unroll
                        for (int g = 0; g < 4; ++g) { u32x2 w; w.x = cvtpk(o[rb][i][4 * g], o[rb][i][4 * g + 1]); w.y = cvtpk(o[rb][i][4 * g + 2], o[rb][i][4 * g + 3]); *(u32x2*)(op + 64 * rb + 32 * i + 8 * g) = w; }
            } else {
                const float m0 = P.sink[h] * LOG2E, m1 = P.sink[h + 1] * LOG2E, l0 = hi == 0 ? 1.f : 0.f;
                f32x16 o[2][2];
                attn_pass2(o, Q + (size_t)myrow * 512 + h * 64, K + (size_t)b * NKV * 128 + kvh * 64, VT + ((size_t)b * 128 + kvh * 64) * NKV,
                           s0a, s0b, s1a, s1b, true, m0, m1, l0, win, qpos, qw0, lds);
                const int tid2 = otid();
                bf16_t* op = O + (size_t)(row0 + (tid2 >> 6) * 32 + (tid2 & 31)) * 512 + h * 64 + 4 * ((tid2 & 63) >> 5);
#pragma unroll
                for (int rb = 0; rb < 2; ++rb)
#pragma unroll
                    for (int i = 0; i < 2; ++i)
#pragma unroll
                        for (int g = 0; g < 4; ++g) { u32x2 w; w.x = cvtpk(o[rb][i][4 * g], o[rb][i][4 * g + 1]); w.y = cvtpk(o[rb][i][4 * g + 2], o[rb][i][4 * g + 3]); *(u32x2*)(op + 64 * rb + 32 * i + 8 * g) = w; }
            }
        }
    }
}

__device__ __forceinline__ int nat_col_of(int n) {
    if (n < 2304) {
        const int s = 4 * (n >> 8) + ((n & 127) >> 5), d = 32 * ((n & 255) >> 7) + (n & 31);
        int base;
        if (s < 8) base = 64 * s; else if (s < 16) base = 512 + 64 * (s - 8); else if (s < 24) base = 1536 + 64 * (s - 16);
        else if (s < 32) base = 2304 + 64 * (s - 24); else if (s < 34) base = 2048 + 64 * (s - 32); else base = 2816 + 64 * (s - 34);
        return base + d;
    }
    if (n < 2816) return 1024 + (n - 2304);
    if (n < 2944) return 2176 + (n - 2816);
    return n;
}
__device__ __forceinline__ void transpose_item(const float* W, int K, int N, bf16_t* WT, int nat0, int out0, int k0, LAS float* scr, int lane) {
#pragma unroll 8
    for (int i = 0; i < 32; ++i) { const int kk = 2 * i + (lane >> 5); scr[kk * 33 + (lane & 31)] = W[(size_t)(k0 + kk) * N + nat0 + (lane & 31)]; }
    asm volatile("s_waitcnt lgkmcnt(0)" ::: "memory");
    const int c = lane & 7;
#pragma unroll
    for (int j = 0; j < 4; ++j) { const int n = (lane >> 3) + 8 * j; const LAS float* s = scr + (8 * c) * 33 + n;
        u32x4 o; o.x = cvtpk(s[0 * 33], s[1 * 33]); o.y = cvtpk(s[2 * 33], s[3 * 33]); o.z = cvtpk(s[4 * 33], s[5 * 33]); o.w = cvtpk(s[6 * 33], s[7 * 33]);
        *(u32x4*)(WT + (size_t)(out0 + n) * K + k0 + 8 * c) = o; }
    asm volatile("s_waitcnt lgkmcnt(0)" ::: "memory");
}
__device__ __forceinline__ void convert_weights(const Args& a, int l, LAS unsigned char* lds) {
    const int tid = otid(), lane = tid & 63, wave = tid >> 6;
    LAS float* scr = (LAS float*)(lds + wave * 16384);
    const int gw = obx() * NWAVES + wave, NGW = gridDim.x * NWAVES;
    constexpr int I_IN = 16 * 192, I_BR = 8 * 32, I_OUT = 16 * 32, I_F1 = 16 * 128, I_F2 = 64 * 32;
    constexpr int NIT = I_IN + 3 * I_BR + I_OUT + I_F1 + I_F2;
    bf16_t* w_in_t = (bf16_t*)(wsp() + WS_WIN); bf16_t* w_br_t = (bf16_t*)(wsp() + WS_WBR); bf16_t* w_out_t = (bf16_t*)(wsp() + WS_WOUT);
    bf16_t* w_f1_t = (bf16_t*)(wsp() + WS_WF1); bf16_t* w_f2_t = (bf16_t*)(wsp() + WS_WF2);
    for (int it = gw; it < NIT; it += NGW) {
        int r = it;
        if (r < I_IN) { const int kb = r / 192, nb = r % 192; transpose_item(inp(I_WIN) + (size_t)l * DM * INW, DM, INW, w_in_t, nat_col_of(32 * nb), 32 * nb, 64 * kb, scr, lane); continue; } r -= I_IN;
        if (r < 3 * I_BR) { const int i = r / I_BR, q = r % I_BR, kb = q / 32, nb = q % 32;
            transpose_item(inp(I_WBR) + ((size_t)l * 1536 + i * 512) * DM, 512, DM, w_br_t + (size_t)i * DM * 512, 32 * nb, 32 * nb, 64 * kb, scr, lane); continue; } r -= 3 * I_BR;
        if (r < I_OUT) { const int kb = r / 32, nb = r % 32; transpose_item(inp(I_WOUT) + (size_t)l * DM * DM, DM, DM, w_out_t, 32 * nb, 32 * nb, 64 * kb, scr, lane); continue; } r -= I_OUT;
        if (r < I_F1) { const int kb = r / 128, nb = r % 128; transpose_item(inp(I_WF1) + (size_t)l * DM * DFF, DM, DFF, w_f1_t, 32 * nb, 32 * nb, 64 * kb, scr, lane); continue; } r -= I_F1;
        { const int kb = r / 32, nb = r % 32; transpose_item(inp(I_WF2) + (size_t)l * DFF * DM, DFF, DM, w_f2_t, 32 * nb, 32 * nb, 64 * kb, scr, lane); }
    }
}
__device__ __forceinline__ float silu_f(float x) { return x / (1.f + __expf(-x)); }

__device__ __forceinline__ void prologue_small(const Args& a, LAS unsigned char* lds) {
    const int tid = otid();
    if (obx() == 0) {
        float* rope = (float*)(wsp() + WS_ROPE);
        for (int e = tid; e < 128 * 16; e += NTHREADS) {
            const int pos = e >> 4, i = e & 15;
            const float invf = exp2f(-(float)i * (13.287712379549449f / 16.f));
            const float ang = (float)pos * invf;
            const float k = rintf(ang * 0.15915494309189535f);
            float r = fmaf(-k, 6.2831854820251465f, ang); r = fmaf(-k, -1.7484555e-7f, r);
            rope[pos * 32 + i] = __cosf(r); rope[pos * 32 + 16 + i] = __sinf(r);
        }
        if (tid < 256) {
            const int l = tid >> 6, i = tid & 63;
            const float s1 = wave_sum(inp(I_LQ1)[l * 64 + i] * inp(I_LK1)[l * 64 + i]);
            const float s2 = wave_sum(inp(I_LQ2)[l * 64 + i] * inp(I_LK2)[l * 64 + i]);
            if (i == 0) ((float*)(wsp() + WS_LAM))[l] = expf(s1) - expf(s2) + lam_init_of(l);
        }
    }
    LAS float* sv = (LAS float*)lds;
    LAS float* red = (LAS float*)(lds + 12288);
    for (int e = tid; e < 3 * 1024; e += NTHREADS) { const int v = e >> 10, k = e & 1023; sv[e] = silu_f(v < 2 ? inp(I_C)[v * 1024 + k] : inp(I_CCTX)[k]); }
    __syncthreads();
    float* mod = (float*)(wsp() + WS_MOD);
    const int col4 = (tid & 31) * 4, ks = tid >> 5;
    for (int item = obx(); item < 4 * 48; item += gridDim.x) {
        const int l = item / 48, n0 = (item % 48) * 128;
        f32x4 a0 = {0.f, 0.f, 0.f, 0.f}, a1 = a0, a2 = a0;
        const float* wp = inp(I_WADA) + ((size_t)l * 1024 + ks * 64) * INW + n0 + col4;
#pragma unroll 4
        for (int kk = 0; kk < 64; ++kk) {
            const f32x4 w = *(const f32x4*)(wp + (size_t)kk * INW); const int k = ks * 64 + kk;
            a0 = a0 + w * sv[k]; a1 = a1 + w * sv[1024 + k]; a2 = a2 + w * sv[2048 + k];
        }
        *(LAS f32x4*)(red + (ks * 3 + 0) * 128 + col4) = a0; *(LAS f32x4*)(red + (ks * 3 + 1) * 128 + col4) = a1; *(LAS f32x4*)(red + (ks * 3 + 2) * 128 + col4) = a2;
        __syncthreads();
        if (tid < 384) {
            const int v = tid >> 7, cidx = tid & 127; float s = inp(I_BADA)[l * INW + n0 + cidx];
#pragma unroll
            for (int q = 0; q < 16; ++q) s += red[(q * 3 + v) * 128 + cidx];
            mod[((size_t)l * 3 + v) * INW + n0 + cidx] = s;
        }
        __syncthreads();
    }
}

__device__ __forceinline__ void row_phase(const Args& a, const float* T, const float* Tc  , float* zc  , const float* modT  , int gm_off, const float* gpost,
                                          const float* modH  , int sh_off, int sc_off, const float* gpre, bool init, bool wrH, int nrows) {
    const int tid = otid(), lane = tid & 63, wave = tid >> 6;
    const int gw = obx() * NWAVES + wave, NGW = gridDim.x * NWAVES;
    float* Y = (float*)(wsp() + WS_Y); bf16_t* H = (bf16_t*)(wsp() + WS_H);
    for (int r = gw; r < nrows; r += NGW) {
        const int mi = r < SEQ ? 0 : (r < ML ? 1 : 2);
        float* xrow = r < ML ? outp() + (size_t)r * DM : Y + (size_t)(r - ML) * DM;
        const float* src = init ? (r < ML ? inp(I_X) + (size_t)r * DM : inp(I_CTX) + (size_t)(r - ML) * DM) : xrow;
        f32x4 x[4];
#pragma unroll
        for (int j = 0; j < 4; ++j) x[j] = *(const f32x4*)(src + 256 * j + 4 * lane);
        if (T) {
            f32x4 t[4]; float ss = 0.f;
            const float* trow = r < ML ? T + (size_t)r * DM : Tc + (size_t)(r - ML) * DM;
#pragma unroll
            for (int j = 0; j < 4; ++j) { t[j] = *(const f32x4*)(trow + 256 * j + 4 * lane);
                if (r >= ML) {
#pragma unroll
                    for (int s = 1; s < 8; ++s) t[j] = t[j] + *(const f32x4*)(trow + (size_t)s * MC * DM + 256 * j + 4 * lane);
                } ss += (t[j][0] * t[j][0] + t[j][1] * t[j][1]) + (t[j][2] * t[j][2] + t[j][3] * t[j][3]); }
            const float rstd = rsqrtf(wave_sum(ss) * (1.f / DM) + 1e-6f);
            const float* gm = modT + (size_t)mi * INW + gm_off;
#pragma unroll
            for (int j = 0; j < 4; ++j) { const int c = 256 * j + 4 * lane; const f32x4 g = *(const f32x4*)(gm + c), gp = *(const f32x4*)(gpost + c); x[j] = x[j] + g * (t[j] * rstd * gp); }
        }
        if (T || init) {
#pragma unroll
            for (int j = 0; j < 4; ++j) *(f32x4*)(xrow + 256 * j + 4 * lane) = x[j];
        }
        if (wrH) {
            float ss = 0.f;
#pragma unroll
            for (int j = 0; j < 4; ++j) ss += (x[j][0] * x[j][0] + x[j][1] * x[j][1]) + (x[j][2] * x[j][2] + x[j][3] * x[j][3]);
            const float rstd = rsqrtf(wave_sum(ss) * (1.f / DM) + 1e-6f);
            const float* sh = modH + (size_t)mi * INW + sh_off; const float* sc = modH + (size_t)mi * INW + sc_off;
#pragma unroll
            for (int j = 0; j < 4; ++j) { const int c = 256 * j + 4 * lane; const f32x4 gp = *(const f32x4*)(gpre + c), s1 = *(const f32x4*)(sc + c), s0 = *(const f32x4*)(sh + c);
                const f32x4 hv = (x[j] * rstd * gp) * (1.f + s1) + s0; u32x2 w; w.x = cvtpk(hv[0], hv[1]); w.y = cvtpk(hv[2], hv[3]); *(u32x2*)(H + (size_t)r * DM + c) = w; }
        }
    }
}

#define XB_TMO      128
#define XB_XCNT(j)  (256  + 64 * (j))
#define XB_XSUB(j)  (1280 + 64 * (j))
#define XB_XGEN(j)  (2304 + 64 * (j))
#define XB_TOP      3328
#define XB_TOPGEN   3392
#define XCD_BAR_WORDS 3456
#define XB_SPIN_CAP (1u << 20)

__device__ __forceinline__ unsigned xb_ld(unsigned* p)              { return __hip_atomic_load(p, __ATOMIC_RELAXED, __HIP_MEMORY_SCOPE_AGENT); }
__device__ __forceinline__ unsigned xb_add(unsigned* p, unsigned v) { return __hip_atomic_fetch_add(p, v, __ATOMIC_RELAXED, __HIP_MEMORY_SCOPE_AGENT); }
__device__ __forceinline__ unsigned xb_xcc_id() { return (unsigned)__builtin_amdgcn_s_getreg((3 << 11) | 20) & 0xFu; }
#define XB_SPIN(cond, bar) do { unsigned _sp = 0; while (cond) { __builtin_amdgcn_s_sleep(1); \
    if ((++_sp & 255u) == 0u) { if (xb_ld(&(bar)[XB_TMO])) break; if (_sp > XB_SPIN_CAP) { atomicAdd(&(bar)[XB_TMO], 1u); break; } } } } while (0)

struct XcdBarrier {
    unsigned* bar; unsigned x;
    volatile LAS unsigned* st;
};

__device__ __forceinline__ XcdBarrier xcd_barrier_post(unsigned* bar, volatile LAS unsigned* st) {
    XcdBarrier b; b.bar = bar; b.x = xb_xcc_id(); b.st = st;
    if (threadIdx.x == 0) (void)xb_add(&bar[XB_XCNT(b.x)], 1u);
    return b;
}
__device__ __forceinline__ void xcd_barrier_complete(unsigned* bar, unsigned x, unsigned& nloc, unsigned& nx) {
    const unsigned G = gridDim.x * gridDim.y * gridDim.z;
    unsigned sum, cnt, mine, sp = 0u;
    for (;;) {
        sum = 0u; cnt = 0u; mine = 0u;
#pragma unroll
        for (unsigned j = 0; j < 16; ++j) { const unsigned c = xb_ld(&bar[XB_XCNT(j)]); sum += c; cnt += (c > 0u) ? 1u : 0u; mine = (j == x) ? c : mine; }
        if (sum == G) break;
        __builtin_amdgcn_s_sleep(1);
        if ((++sp & 255u) == 0u) { if (xb_ld(&bar[XB_TMO])) break; if (sp > XB_SPIN_CAP) { atomicAdd(&bar[XB_TMO], 1u); break; } }
    }
    nloc = mine > 0u ? mine : 1u; nx = cnt > 0u ? cnt : 1u;
}

__device__ __forceinline__ void xcd_barrier(const XcdBarrier& b) {
    asm volatile("s_waitcnt vmcnt(0)" ::: "memory");
    __syncthreads();
    if (threadIdx.x == 0) {
        unsigned* bar = b.bar;
        __builtin_amdgcn_s_waitcnt(0);
        unsigned nloc = b.st[0], nx = b.st[1];
        if (nloc == 0u) { xcd_barrier_complete(bar, b.x, nloc, nx); b.st[0] = nloc; b.st[1] = nx; }
        const unsigned old = xb_add(&bar[XB_XSUB(b.x)], 1u);
        const unsigned gen = old / nloc;
        if (old + 1u == (gen + 1u) * nloc) {
            __builtin_amdgcn_fence(__ATOMIC_RELEASE, "agent");
            asm volatile("s_waitcnt vmcnt(0)" ::: "memory");
            const unsigned og = xb_add(&bar[XB_TOP], 1u);
            const unsigned tg = og / nx;
            if (og + 1u == (tg + 1u) * nx) xb_add(&bar[XB_TOPGEN], 1u);
            else XB_SPIN(xb_ld(&bar[XB_TOPGEN]) == tg, bar);
            __builtin_amdgcn_fence(__ATOMIC_ACQUIRE, "agent");
            xb_add(&bar[XB_XGEN(b.x)], 1u);
            asm volatile("s_waitcnt vmcnt(0)" ::: "memory");
        } else {
            XB_SPIN(xb_ld(&bar[XB_XGEN(b.x)]) == gen, bar);
            __builtin_amdgcn_fence(__ATOMIC_ACQUIRE, "agent");
            asm volatile("s_waitcnt vmcnt(0)" ::: "memory");
        }
    }
    __syncthreads();
}

__global__ void __launch_bounds__(NTHREADS) mega_fwd(Args a) {
    extern __shared__ __attribute__((aligned(16))) unsigned char lds_raw[];
    LAS unsigned char* lds = (LAS unsigned char*)lds_raw;
    cg::grid_group grid = cg::this_grid();
    volatile LAS unsigned* xst = (volatile LAS unsigned*)(lds + 131328);
    if (otid() == 0) { xst[0] = 0u; xst[1] = 0u; }
    __syncthreads();
    (void)xcd_barrier_post((unsigned*)(wsp() + WS_BAR), xst);
#define GSYNC() do { XcdBarrier b_; b_.bar = (unsigned*)(wsp() + WS_BAR); b_.x = xb_xcc_id(); b_.st = xst; xcd_barrier(b_); } while (0)
#define WSP(T, off) ((T*)(wsp() + (off)))
#define MODL(l) (WSP(const float, WS_MOD) + (size_t)(l) * 3 * INW)
    prologue_small(a, lds);
    convert_weights(a, 0, lds);
    grid.sync();
    row_phase(a, nullptr, nullptr, WSP(float, WS_TCO), MODL(0), 0, nullptr, MODL(0), 0, 1024, inp(I_GPREMIX), true, true, MT);
    GSYNC();

#pragma unroll 1
    for (int l = 0; l < DEPTH; ++l) {
        const int MR = (l < DEPTH - 1) ? MT : ML;
#ifndef NO_G1
        { pg8::Gemm g{WSP(bf16_t, WS_H), WSP(bf16_t, WS_WIN), MT, INW, DM}; pg8::StaticOrder S; S.init(MT, INW, (int)gridDim.x, obx());
          EpiG1 E{wsp() + WS_R, WSP(const float, WS_ROPE), inp(I_GQ) + l * 64, inp(I_GK) + l * 64};
          pg8::gemm_phase<EpiG1, pg8::StaticOrder, true, true>(lds, g, S, E); }
#endif
        GSYNC();
#ifndef NO_ATT
        { AttnPtrs P{wsp() + WS_R, WSP(bf16_t, WS_O), WSP(float, WS_SCR), inp(I_GSUB) + l * 128, inp(I_SINK) + l * 8, WSP(const float, WS_LAM), l};
          attn_phase(P, l < DEPTH - 1, lds); }
#endif
        GSYNC();
#ifndef NO_MRG
        { pg8::StaticOrder S; S.init(MR, DM, (int)gridDim.x, obx());
          { pg8::Gemm g{WSP(bf16_t, WS_O), WSP(bf16_t, WS_WBR), MR, DM, 512}; EpiMerge<0> E{WSP(bf16_t, WS_R + R_G), WSP(bf16_t, WS_R + R_T12), WSP(bf16_t, WS_H)};
            pg8::gemm_phase<EpiMerge<0>, pg8::StaticOrder, true, true>(lds, g, S, E); }
          { pg8::Gemm g{WSP(bf16_t, WS_O) + (size_t)MT * 512, WSP(bf16_t, WS_WBR) + (size_t)DM * 512, MR, DM, 512}; EpiMerge<1> E{WSP(bf16_t, WS_R + R_G), WSP(bf16_t, WS_R + R_T12), WSP(bf16_t, WS_H)};
            pg8::gemm_phase<EpiMerge<1>, pg8::StaticOrder, true, true>(lds, g, S, E); }
          { pg8::Gemm g{WSP(bf16_t, WS_O) + (size_t)2 * MT * 512, WSP(bf16_t, WS_WBR) + (size_t)2 * DM * 512, MR, DM, 512}; EpiMerge<2> E{WSP(bf16_t, WS_R + R_G), WSP(bf16_t, WS_R + R_T12), WSP(bf16_t, WS_H)};
            pg8::gemm_phase<EpiMerge<2>, pg8::StaticOrder, true, true>(lds, g, S, E); } }
#endif
        GSYNC();
#ifndef NO_OUT
        { pg8::Gemm g{WSP(bf16_t, WS_H), WSP(bf16_t, WS_WOUT), MR, DM, DM}; CtxSplitOrder S; S.init(DM, DM, (int)gridDim.x, obx(), l < DEPTH - 1); EpiF32Split E{WSP(float, WS_R + R_T12), WSP(float, WS_TCO), DM / 8};
          pg8::gemm_phase<EpiF32Split, CtxSplitOrder, true, true>(lds, g, S, E); }
#endif
        GSYNC();
        row_phase(a, WSP(const float, WS_R + R_T12), WSP(const float, WS_TCO), WSP(float, WS_TCF), MODL(l), 2048, inp(I_GPOSTMIX) + l * DM, MODL(l), 3072, 4096, inp(I_GPREFF) + l * DM, false, true, MR);
        GSYNC();
#ifndef NO_FFN
        { pg8::Gemm g{WSP(bf16_t, WS_H), WSP(bf16_t, WS_WF1), MR, DFF, DM}; pg8::StaticOrder S; S.init(MR, DFF, (int)gridDim.x, obx()); EpiSqRelu E{WSP(bf16_t, WS_R + R_U), DFF};
          pg8::gemm_phase<EpiSqRelu, pg8::StaticOrder, true, true>(lds, g, S, E); }
        GSYNC();
        { pg8::Gemm g{WSP(bf16_t, WS_R + R_U), WSP(bf16_t, WS_WF2), MR, DM, DFF}; CtxSplitOrder S; S.init(DM, DFF, (int)gridDim.x, obx(), l < DEPTH - 1); EpiF32Split E{WSP(float, WS_R + R_T3), WSP(float, WS_TCF), DFF / 8};
          pg8::gemm_phase<EpiF32Split, CtxSplitOrder, true, true>(lds, g, S, E); }
#endif
        GSYNC();
        if (l < DEPTH - 1) {
            row_phase(a, WSP(const float, WS_R + R_T3), WSP(const float, WS_TCF), WSP(float, WS_TCO), MODL(l), 5120, inp(I_GPOSTFF) + l * DM, MODL(l + 1), 0, 1024, inp(I_GPREMIX) + (l + 1) * DM, false, true, MT);
            convert_weights(a, l + 1, lds);
            GSYNC();
        } else {
            row_phase(a, WSP(const float, WS_R + R_T3), WSP(const float, WS_TCF), nullptr, MODL(l), 5120, inp(I_GPOSTFF) + l * DM, MODL(l), 0, 1024, inp(I_GPREMIX), false, false, ML);
        }
    }
}

extern "C" void kernel_launch(void* const* d_in, const int* in_sizes, int n_in, void* d_out, int out_size, void* d_ws, size_t ws_size, hipStream_t stream) {
    static int grid = 0;
    if (grid == 0) {
        if (n_in != 23 || ws_size < WS_END) { fprintf(stderr, "kernel_launch: unexpected n_in %d / ws %zu (need %zu)\n", n_in, ws_size, (size_t)WS_END); grid = -1; return; }
        int dev = 0, cus = 0, per_cu = 0;
        hipGetDevice(&dev);
        hipDeviceGetAttribute(&cus, hipDeviceAttributeMultiprocessorCount, dev);
        if (hipFuncSetAttribute((const void*)mega_fwd, hipFuncAttributeMaxDynamicSharedMemorySize, LDS_BYTES) != hipSuccess) { fprintf(stderr, "kernel_launch: hipFuncSetAttribute failed\n"); }
        if (hipOccupancyMaxActiveBlocksPerMultiprocessor(&per_cu, (const void*)mega_fwd, NTHREADS, LDS_BYTES) != hipSuccess || per_cu < 1) per_cu = 1;
        (void)hipGetLastError();
        grid = cus * per_cu;
    }
    if (grid < 0) return;
    Args a{};
    for (int i = 0; i < 23; ++i) a.in[i] = (const float*)d_in[i];
    a.out = (float*)d_out; a.ws = (unsigned char*)d_ws;
    (void)hipMemsetAsync((char*)d_ws + WS_BAR, 0, 16384, stream);
    void* args[] = {&a};
    hipError_t e = hipLaunchCooperativeKernel((const void*)mega_fwd, dim3(grid), dim3(NTHREADS), args, LDS_BYTES, stream);
    if (e != hipSuccess) fprintf(stderr, "cooperative launch failed: %s (grid %d)\n", hipGetErrorString(e), grid);
}
```
